# Optimizing an MI355X kernel written in HIP

```python
import math
import jax, jax.numpy as jnp
from jax import lax
import numpy as np

D_MODEL = 1024
BATCH = 8
SEQ = 4096
DEPTH = 2

HEAD_DIM = 64
SB_HEADS = 8
DIFF_HEADS = 4
SB_WIDTH = SB_HEADS * HEAD_DIM
DIFF_QK_WIDTH = DIFF_HEADS * 2 * HEAD_DIM
DIFF_VDIM = 2 * HEAD_DIM
DIFF_WIDTH = DIFF_HEADS * DIFF_VDIM
MIX_WIDTH = SB_WIDTH + DIFF_WIDTH
QKV_WIDTH = 3 * SB_WIDTH + 2 * DIFF_QK_WIDTH + DIFF_WIDTH
SPLITS = [SB_WIDTH, 2 * SB_WIDTH, 3 * SB_WIDTH,
          3 * SB_WIDTH + DIFF_QK_WIDTH, 3 * SB_WIDTH + 2 * DIFF_QK_WIDTH]
Q_BLOCK = 128
N_BUCKETS = 32
MAX_DISTANCE = 128
D_FF_DENSE = 2816
N_EXPERTS = 8
TOP_K = 2
D_FF_EXPERT = 3584
MOE_BLOCK = 128
N_DENSE = (DEPTH + 1) // 2
N_MOE = DEPTH // 2
NORM_EPS = 1e-6

kernel_name = "hybrid_stickbreak_diffattn_moe"


def rms_norm(x, g):
    xf = x.astype(jnp.float32)
    y = xf * lax.rsqrt(jnp.mean(xf * xf, axis=-1, keepdims=True) + NORM_EPS)
    return (y * g.astype(jnp.float32)).astype(x.dtype)


def t5_causal_bucket(n):
    max_exact = N_BUCKETS // 2
    nf = jnp.maximum(n, 1).astype(jnp.float32)
    large = max_exact + (jnp.log(nf / max_exact) / math.log(MAX_DISTANCE / max_exact)
                         * (N_BUCKETS - max_exact)).astype(jnp.int32)
    large = jnp.minimum(large, N_BUCKETS - 1)
    return jnp.where(n < max_exact, n, large)


def stick_breaking_attention(q, k, v):
    S = q.shape[1]
    scale = HEAD_DIM ** -0.5
    outs = []
    for blk in range(S // Q_BLOCK):
        q0 = blk * Q_BLOCK
        kl = q0 + Q_BLOCK
        z = jnp.einsum('bqhd,bkhd->bhqk', q[:, q0:kl], k[:, :kl]).astype(jnp.float32) * scale
        t_pos = q0 + jnp.arange(Q_BLOCK)[:, None]
        s_pos = jnp.arange(kl)[None, :]
        mask = s_pos < t_pos
        log_stay = jnp.where(mask, jax.nn.log_sigmoid(-z), 0.0)
        between = lax.cumsum(log_stay, axis=3, reverse=True) - log_stay
        a = jnp.where(mask, jnp.exp(jax.nn.log_sigmoid(z) + between), 0.0)
        outs.append(jnp.einsum('bhqk,bkhd->bqhd', a.astype(v.dtype), v[:, :kl]))
    return jnp.concatenate(outs, axis=1)


def differential_attention(q, k, v, bias_by_dist, lam):
    S = q.shape[1]
    scale = HEAD_DIM ** -0.5
    outs = []
    for blk in range(S // Q_BLOCK):
        q0 = blk * Q_BLOCK
        kl = q0 + Q_BLOCK
        z = jnp.einsum('bqhcd,bkhcd->bhcqk', q[:, q0:kl], k[:, :kl]).astype(jnp.float32) * scale
        dist = (q0 + jnp.arange(Q_BLOCK)[:, None]) - jnp.arange(kl)[None, :]
        bias = jnp.take(bias_by_dist, jnp.maximum(dist, 0), axis=0)
        z = z + jnp.transpose(bias, (2, 0, 1))[None, :, None]
        z = jnp.where(dist >= 0, z, -jnp.inf)
        p = jax.nn.softmax(z, axis=-1)
        w = p[:, :, 0] - lam * p[:, :, 1]
        outs.append(jnp.einsum('bhqk,bkhe->bqhe', w.astype(v.dtype), v[:, :kl]))
    return jnp.concatenate(outs, axis=1)


def swiglu(h, w_gate, w_up, w_down):
    return (jax.nn.silu(h @ w_gate) * (h @ w_up)) @ w_down


def moe_swiglu(h, router_w, w_gate, w_up, w_down):
    B, S, D = h.shape
    n = B * S
    xf = h.reshape(n, D)
    logits = jnp.dot(xf.astype(jnp.float32), router_w.astype(jnp.float32))
    top_logit, top_idx = lax.top_k(logits, TOP_K)
    gates = jax.nn.softmax(top_logit, axis=-1)
    n_assign = n * TOP_K
    expert_ids = top_idx.reshape(-1)
    token_ids = jnp.arange(n_assign, dtype=jnp.int32) // TOP_K
    order = jnp.argsort(expert_ids)
    sorted_exp = expert_ids[order]
    sorted_tok = token_ids[order]
    sorted_gate = gates.reshape(-1)[order]
    counts = jnp.bincount(expert_ids, length=N_EXPERTS)
    starts = jnp.cumsum(counts) - counts
    padded = (counts + MOE_BLOCK - 1) // MOE_BLOCK * MOE_BLOCK
    pad_ends = jnp.cumsum(padded)
    pad_starts = pad_ends - padded
    dest = pad_starts[sorted_exp] + (jnp.arange(n_assign, dtype=jnp.int32) - starts[sorted_exp])
    n_blocks = -(-n_assign // MOE_BLOCK) + N_EXPERTS
    cap = n_blocks * MOE_BLOCK
    buf = jnp.zeros((cap, D), xf.dtype).at[dest].set(xf[sorted_tok])
    block_exp = jnp.minimum(
        jnp.searchsorted(pad_ends, jnp.arange(n_blocks, dtype=jnp.int32) * MOE_BLOCK, side='right'),
        N_EXPERTS - 1)

    def expert_block(args):
        xb, e = args
        return swiglu(xb, w_gate[e], w_up[e], w_down[e])

    yb = lax.map(expert_block, (buf.reshape(n_blocks, MOE_BLOCK, D), block_exp))
    y = yb.reshape(cap, D)[dest] * sorted_gate[:, None].astype(xf.dtype)
    out = jax.ops.segment_sum(y, sorted_tok, num_segments=n)
    return out.reshape(B, S, D)


def setup_inputs(seed: int = 0) -> dict:
    key = jax.random.key(seed)
    ks = jax.random.split(key, 24)
    f32 = jnp.float32
    nrm = lambda k, shape, s: jax.random.normal(k, shape, f32) * s
    gain = lambda k, shape: 1.0 + 0.02 * jax.random.normal(k, shape, f32)
    return {
        "x": jax.random.normal(ks[0], (BATCH, SEQ, D_MODEL), f32),
        "w_in": nrm(ks[1], (DEPTH, D_MODEL, QKV_WIDTH), D_MODEL ** -0.5),
        "w_out": nrm(ks[2], (DEPTH, MIX_WIDTH, D_MODEL), MIX_WIDTH ** -0.5),
        "attn_norm": gain(ks[3], (DEPTH, D_MODEL)),
        "ffn_norm": gain(ks[4], (DEPTH, D_MODEL)),
        "sb_out_norm": gain(ks[5], (DEPTH, HEAD_DIM)),
        "diff_subln": gain(ks[6], (DEPTH, DIFF_VDIM)),
        "lambda_q1": nrm(ks[7], (DEPTH, HEAD_DIM), 0.1),
        "lambda_k1": nrm(ks[8], (DEPTH, HEAD_DIM), 0.1),
        "lambda_q2": nrm(ks[9], (DEPTH, HEAD_DIM), 0.1),
        "lambda_k2": nrm(ks[10], (DEPTH, HEAD_DIM), 0.1),
        "rel_bias": nrm(ks[11], (N_BUCKETS, DIFF_HEADS), 0.5),
        "dense_w_gate": nrm(ks[12], (N_DENSE, D_MODEL, D_FF_DENSE), D_MODEL ** -0.5),
        "dense_w_up": nrm(ks[13], (N_DENSE, D_MODEL, D_FF_DENSE), D_MODEL ** -0.5),
        "dense_w_down": nrm(ks[14], (N_DENSE, D_FF_DENSE, D_MODEL), D_FF_DENSE ** -0.5),
        "router_w": nrm(ks[15], (N_MOE, D_MODEL, N_EXPERTS), D_MODEL ** -0.5),
        "expert_w_gate": nrm(ks[16], (N_MOE, N_EXPERTS, D_MODEL, D_FF_EXPERT), D_MODEL ** -0.5),
        "expert_w_up": nrm(ks[17], (N_MOE, N_EXPERTS, D_MODEL, D_FF_EXPERT), D_MODEL ** -0.5),
        "expert_w_down": nrm(ks[18], (N_MOE, N_EXPERTS, D_FF_EXPERT, D_MODEL), D_FF_EXPERT ** -0.5),
        "final_norm": gain(ks[19], (D_MODEL,)),
    }


def reference(x, w_in, w_out, attn_norm, ffn_norm, sb_out_norm, diff_subln,
              lambda_q1, lambda_k1, lambda_q2, lambda_k2, rel_bias,
              dense_w_gate, dense_w_up, dense_w_down, router_w,
              expert_w_gate, expert_w_up, expert_w_down, final_norm):
    B, S, _ = x.shape
    bias_by_dist = rel_bias.astype(jnp.float32)[t5_causal_bucket(jnp.arange(S, dtype=jnp.int32))]
    for i in range(DEPTH):
        h = rms_norm(x, attn_norm[i])
        proj = jnp.einsum('bsd,de->bse', h, w_in[i])
        sb_q, sb_k, sb_v, df_q, df_k, df_v = jnp.split(proj, SPLITS, axis=-1)
        sb = stick_breaking_attention(sb_q.reshape(B, S, SB_HEADS, HEAD_DIM),
                                      sb_k.reshape(B, S, SB_HEADS, HEAD_DIM),
                                      sb_v.reshape(B, S, SB_HEADS, HEAD_DIM))
        sb = rms_norm(sb, sb_out_norm[i]).reshape(B, S, SB_WIDTH)
        lambda_init = 0.8 - 0.6 * math.exp(-0.3 * i)
        lam = (jnp.exp(jnp.sum(lambda_q1[i].astype(jnp.float32) * lambda_k1[i].astype(jnp.float32)))
               - jnp.exp(jnp.sum(lambda_q2[i].astype(jnp.float32) * lambda_k2[i].astype(jnp.float32)))
               + lambda_init)
        df = differential_attention(df_q.reshape(B, S, DIFF_HEADS, 2, HEAD_DIM),
                                    df_k.reshape(B, S, DIFF_HEADS, 2, HEAD_DIM),
                                    df_v.reshape(B, S, DIFF_HEADS, DIFF_VDIM),
                                    bias_by_dist, lam)
        df = (rms_norm(df, diff_subln[i]) * (1.0 - lambda_init)).reshape(B, S, DIFF_WIDTH)
        x = x + jnp.einsum('bse,ed->bsd', jnp.concatenate([sb, df], axis=-1), w_out[i])
        h2 = rms_norm(x, ffn_norm[i])
        if i % 2 == 0:
            j = i // 2
            x = x + swiglu(h2, dense_w_gate[j], dense_w_up[j], dense_w_down[j])
        else:
            j = i // 2
            x = x + moe_swiglu(h2, router_w[j], expert_w_gate[j], expert_w_up[j], expert_w_down[j])
    return rms_norm(x, final_norm)
```

```cpp
#include <hip/hip_runtime.h>
#include <cstdio>
#include <cstdint>
#include <type_traits>

#ifndef MK_SKIP
#define MK_SKIP 0
#endif
#ifndef MK_DUP
#define MK_DUP 0
#endif
#ifndef DENSE_FP8
#define DENSE_FP8 0
#endif
static_assert(DENSE_FP8 == 0, "superseded by DENSE_GU_FP8");
#ifndef DENSE_GU_FP8
#define DENSE_GU_FP8 1
#endif
#ifndef DENSE_DOWN_FP8
#define DENSE_DOWN_FP8 0
#endif
#define GAS __attribute__((address_space(1)))
#define LAS __attribute__((address_space(3)))

typedef unsigned short bf16_t;
typedef short bf16x8 __attribute__((ext_vector_type(8)));
typedef short s16x4 __attribute__((ext_vector_type(4)));
typedef float f32x4 __attribute__((ext_vector_type(4)));
typedef float f32x16 __attribute__((ext_vector_type(16)));
typedef unsigned u32x4 __attribute__((ext_vector_type(4)));
typedef unsigned u32x2 __attribute__((ext_vector_type(2)));

constexpr int BATCH = 8, SEQ = 4096, DM = 1024, M = BATCH * SEQ;
constexpr int QKV = 3072;
constexpr int FFD = 2816, NGU_D = 2 * FFD;
constexpr int NE = 8, FFE = 3584, NGU_E = 2 * FFE;
constexpr int MOE_TILES = M / 256 + NE, MOE_ROWS = MOE_TILES * 256;
constexpr float NORM_EPS = 1e-6f;
constexpr float LOG2E = 1.4426950408889634f;
constexpr float C2 = 0.125f * LOG2E;

constexpr size_t MiB = 1u << 20;
constexpr size_t WS_CTL = 0, CTL_ZERO_BYTES = 32 * 1024;
constexpr size_t WS_TOKE = 1 * MiB;
constexpr size_t WS_TOKP = WS_TOKE + 2 * (size_t)M * 4;
constexpr size_t WS_TOKG = WS_TOKP + 2 * (size_t)M * 4;
constexpr size_t WS_ROWT = WS_TOKG + 2 * (size_t)M * 4;
constexpr size_t WS_ROWG = WS_ROWT + 2 * (size_t)MOE_ROWS * 4;
static_assert(WS_ROWG + 2 * (size_t)MOE_ROWS * 4 <= 8 * MiB, "small tables");
constexpr size_t WS_SSQ = 4 * MiB;
constexpr size_t WS_WIN = 8 * MiB;
constexpr size_t WS_WOUT = 20 * MiB;
constexpr size_t WS_WGU = 24 * MiB;
constexpr size_t WS_WD = 35 * MiB;
constexpr size_t WS_EGU = 41 * MiB;
constexpr size_t WS_EGU8 = WS_EGU;
constexpr size_t WS_ACT8 = WS_EGU + 64 * MiB;
constexpr size_t WS_ED = 153 * MiB;
constexpr size_t WS_ACT = 209 * MiB;
constexpr size_t WS_BIG = 273 * MiB;
constexpr size_t WS_HB1 = WS_BIG + 128 * MiB;
constexpr size_t WS_XB = WS_BIG + 192 * MiB;
constexpr size_t WS_END = 529 * MiB;
static_assert(WS_XB + (size_t)M * DM * 2 <= WS_END && WS_BIG + (size_t)M * QKV * 2 <= WS_XB, "XB");
static_assert(WS_HB1 + (size_t)73 * 256 * FFE <= WS_XB && WS_BIG + (size_t)MOE_TILES * 256 * FFE <= WS_HB1, "d_ws map");
constexpr int CW_TMO = 0, CW_CODE = 1;
constexpr int CW_CNT = 64;
constexpr int CW_BAR = 4096;

constexpr int RING_OFF = 0, RING_BYTES = 131072;
constexpr int LDSCTL_OFF = RING_BYTES, MISC_OFF = LDSCTL_OFF + 320;
constexpr int TBL_OFF = LDSCTL_OFF + 1024;
constexpr int GTAB_OFF = TBL_OFF + 2304;
constexpr int ZERO_OFF = GTAB_OFF + 768;
constexpr int BT_OFF = ZERO_OFF + 512, BT_N = 328;
constexpr int LDS_BYTES = BT_OFF + 4 * 4 * BT_N * 4;
static_assert(LDS_BYTES <= 163840 && BT_OFF % 16 == 0, "LDS map");
constexpr int NWAVES = 8;

#define RLX_AGENT __ATOMIC_RELAXED, __HIP_MEMORY_SCOPE_AGENT
#define LDS_WAIT() asm volatile("s_waitcnt lgkmcnt(0)" ::: "memory")
#define VM_WAIT() asm volatile("s_waitcnt vmcnt(0)" ::: "memory")

__device__ __forceinline__ unsigned f2bf(float f) { unsigned u = __builtin_bit_cast(unsigned, f); return (u + 0x7fffu + ((u >> 16) & 1u)) >> 16; }
__device__ __forceinline__ unsigned pk2(float lo, float hi) { return f2bf(lo) | (f2bf(hi) << 16); }
typedef float f32x2_t __attribute__((ext_vector_type(2))); typedef __bf16 bf16x2_t __attribute__((ext_vector_type(2)));
__device__ __forceinline__ unsigned cvt_pk_bf16(float lo, float hi) { f32x2_t v = {lo, hi}; bf16x2_t b = __builtin_convertvector(v, bf16x2_t); return __builtin_bit_cast(unsigned, b); }
__device__ __forceinline__ unsigned pk4_fp8(float a, float b, float c, float d) {
    a = __builtin_amdgcn_fmed3f(a, -448.f, 448.f); b = __builtin_amdgcn_fmed3f(b, -448.f, 448.f); c = __builtin_amdgcn_fmed3f(c, -448.f, 448.f); d = __builtin_amdgcn_fmed3f(d, -448.f, 448.f);
    int w = 0; w = __builtin_amdgcn_cvt_pk_fp8_f32(a, b, w, false); w = __builtin_amdgcn_cvt_pk_fp8_f32(c, d, w, true); return (unsigned)w; }
__device__ __forceinline__ float bf_lo(unsigned w) { return __builtin_bit_cast(float, w << 16); }
__device__ __forceinline__ float bf_hi(unsigned w) { return __builtin_bit_cast(float, w & 0xffff0000u); }
template <int CTRL> __device__ __forceinline__ float dpp_f(float v) { return __builtin_bit_cast(float, __builtin_amdgcn_update_dpp(0, __builtin_bit_cast(int, v), CTRL, 0xF, 0xF, true)); }
__device__ __forceinline__ float sum16(float v) {
    v += dpp_f<0xB1>(v); v += dpp_f<0x4E>(v); v += dpp_f<0x141>(v); v += dpp_f<0x140>(v); return v; }
__device__ __forceinline__ float xor16_sum(float v) { auto rr = __builtin_amdgcn_permlane16_swap(__builtin_bit_cast(unsigned, v), __builtin_bit_cast(unsigned, v), false, false); const unsigned r0 = rr[0], r1 = rr[1]; return __uint_as_float(r0) + __uint_as_float(r1); }
__device__ __forceinline__ float xor32_sum(float v) { auto rr = __builtin_amdgcn_permlane32_swap(__builtin_bit_cast(unsigned, v), __builtin_bit_cast(unsigned, v), false, false); const unsigned r0 = rr[0], r1 = rr[1]; return __uint_as_float(r0) + __uint_as_float(r1); }
__device__ __forceinline__ float sum32(float v) { return xor16_sum(sum16(v)); }
__device__ __forceinline__ float wave_sum(float v) { return xor32_sum(xor16_sum(sum16(v))); }

namespace pg8 {
constexpr int BM = 256, BK = 64, HALF = 128, HTB = HALF * BK * 2, NXCD = 8, WGM = 8;
__host__ __device__ __forceinline__ int lds_byte(int r, int c) { const int st = (r >> 4) * 2 + (c >> 5), rr = r & 15, cc = c & 31, ob = rr * 64 + cc * 2; return st * 1024 + (ob ^ (((ob >> 9) & 1) << 5)); }
__host__ __device__ __forceinline__ void stage_rc(int b, int& R, int& C) { const int st = b / 1024, sb = b % 1024, swz = sb ^ (((sb >> 9) & 1) << 5); R = (st >> 1) * 16 + swz / 64; C = (st & 1) * 32 + (swz % 64) / 2; }
__host__ __device__ __forceinline__ int perm32(int rho) { const int n = rho >> 4, i = rho & 15; return 8 * (i >> 2) + 4 * n + (i & 3); }

struct Unit { int pm, pn; };
struct Gemm { const bf16_t* A; const bf16_t* Bt; int K; int sx = 0x7F7F7F7F; int su = 0x7A7A7A7A; };

struct StaticOrder {
    int nM, nN, nwg, G, c;
    __device__ void init(int nM_, int nN_, int G_, int c_) { nM = nM_; nN = nN_; nwg = nM * nN; G = G_; c = c_; }
    __device__ bool next(int i, Unit& u) const { const long L = (long)i * G + c; if (L >= nwg) return false; unit_at(L, u); return true; }
    __device__ void unit_at(long L, Unit& u) const {
        int wgid = (int)L; { const int q = nwg / NXCD, r = nwg % NXCD, xcd = wgid % NXCD, off = wgid / NXCD; wgid = (xcd < r ? xcd * (q + 1) : r * (q + 1) + (xcd - r) * q) + off; }
        const int nig = WGM * nN, gid = wgid / nig, fm = gid * WGM, gsz = (nM - fm) < WGM ? (nM - fm) : WGM;
        u.pm = fm + ((wgid % nig) % gsz); u.pn = (wgid % nig) / gsz;
    }
};
struct ChunkOrder {
    StaticOrder S; int t0; const volatile LAS int* tend; int xe, li, nl, E;
    __device__ bool next(int i, Unit& u) const {
        const long L = (i < xe) ? (long)li + (long)i * nl : (long)E + S.c + (long)(i - xe) * S.G;
        if (L >= S.nwg) return false;
        S.unit_at(L, u); u.pm += t0;
        typedef int te4_t __attribute__((ext_vector_type(4)));
        const LAS te4_t* tp = (const LAS te4_t*)tend; const te4_t ta = tp[0], tb = tp[1];
        const int e = ((u.pm >= ta.x) ? 1 : 0) + ((u.pm >= ta.y) ? 1 : 0) + ((u.pm >= ta.z) ? 1 : 0) + ((u.pm >= ta.w) ? 1 : 0) + ((u.pm >= tb.x) ? 1 : 0) + ((u.pm >= tb.y) ? 1 : 0) + ((u.pm >= tb.z) ? 1 : 0);
        u.pn += e * S.nN; return true;
    }
};

typedef int v8i __attribute__((ext_vector_type(8))); typedef int v4i __attribute__((ext_vector_type(4)));
__device__ __forceinline__ v8i ld32(const LAS unsigned char* p) { const v4i a = *(const LAS v4i*)p, b = *(const LAS v4i*)(p + 16); return __builtin_shufflevector(a, b, 0, 1, 2, 3, 4, 5, 6, 7); }
template <class Epi, class Sched, bool ALIGN_EPI, bool GATHER, bool FP8 = false>
__device__ __forceinline__ void gemm_phase(LAS unsigned char* lds, const Gemm g, const Sched& S, const Epi& E, const int* rowidx, const int tid) {
    const int wid = __builtin_amdgcn_readfirstlane(tid >> 6), lane = tid & 63, wr = wid >> 2, wc = wid & 3, fr = lane & 15, fq = lane >> 4;
    const int rb = FP8 ? g.K : 2 * g.K; int nt = rb / 128;
    if constexpr (FP8) asm volatile("" : "+s"(nt));
    unsigned voffA[2], voffB[2];
#pragma unroll
    for (int i = 0; i < 2; ++i) { int R, C; stage_rc(tid * 16 + i * 8192, R, C); const int Rb = (R & ~31) + perm32(R & 31);
        voffA[i] = (unsigned)(R * rb + 2 * C); voffB[i] = (unsigned)(Rb * rb + 2 * C); }
    const size_t kstep = (size_t)(BK * 2);
    const size_t hstep = (size_t)HALF * rb;
    const size_t tstep = 2 * hstep;
    const unsigned ldsw = (unsigned)wid * 1024u;
    const int aoff = lds_byte(wr * 64 + fr, FP8 ? fq * 16 : fq * 8), boff = lds_byte(wc * 32 + fr, FP8 ? fq * 16 : fq * 8);
#define PG8_SA(b, h) (((b) * 2 + (h)) * HTB)
#define PG8_SB(b, h) ((4 + (b) * 2 + (h)) * HTB)
#define PG8_STAGE(bufoff, gbase, voff) do { _Pragma("unroll") for (int _i = 0; _i < 2; ++_i) \
        __builtin_amdgcn_global_load_lds((const unsigned*)((const char*)(gbase) + (voff)[_i]), (LAS unsigned*)(lds + (bufoff) + ldsw + _i * 8192), 16, 0, 0); } while (0)
#define PG8_LDA(dst, b, h) do { if constexpr (FP8) { _Pragma("unroll") for (int m = 0; m < 4; ++m) dst##8[m] = ld32(lds + PG8_SA(b, h) + aoff + m * 2048); } \
        else { _Pragma("unroll") for (int m = 0; m < 4; ++m) _Pragma("unroll") for (int k = 0; k < 2; ++k) dst[m][k] = *(const LAS bf16x8*)(lds + PG8_SA(b, h) + aoff + m * 2048 + k * 1024); } } while (0)
#define PG8_LDB(dst, b, h) do { if constexpr (FP8) { _Pragma("unroll") for (int n = 0; n < 2; ++n) dst##8[n] = ld32(lds + PG8_SB(b, h) + boff + n * 2048); } \
        else { _Pragma("unroll") for (int n = 0; n < 2; ++n) _Pragma("unroll") for (int k = 0; k < 2; ++k) dst[n][k] = *(const LAS bf16x8*)(lds + PG8_SB(b, h) + boff + n * 2048 + k * 1024); } } while (0)
#define PG8_MMA(ai, bj, At, Bt) do { __builtin_amdgcn_s_setprio(1); \
        if constexpr (FP8) { _Pragma("unroll") for (int m = 0; m < 4; ++m) _Pragma("unroll") for (int n = 0; n < 2; ++n) \
            asm volatile("v_mfma_scale_f32_16x16x128_f8f6f4 %0, %1, %2, %0, %3, %4 op_sel_hi:[0,0,0]" : "+v"(acc[ai][bj][m][n]) : "v"(Bt##8[n]), "v"(At##8[m]), "v"((bj) ? sc_u : sc_w), "v"(sc_x)); } \
        else { _Pragma("unroll") for (int m = 0; m < 4; ++m) _Pragma("unroll") for (int n = 0; n < 2; ++n) _Pragma("unroll") for (int k = 0; k < 2; ++k) \
            acc[ai][bj][m][n] = __builtin_amdgcn_mfma_f32_16x16x32_bf16(Bt[n][k], At[m][k], acc[ai][bj][m][n], 0, 0, 0); } \
        __builtin_amdgcn_s_setprio(0); } while (0)
#define PG8_WAIT_V(n) asm volatile("s_waitcnt vmcnt(" #n ")" ::: "memory")
#define PG8_WAIT_L(n) asm volatile("s_waitcnt lgkmcnt(" #n ")" ::: "memory")
#define PG8_BAR __builtin_amdgcn_s_barrier()
#define PG8_SCHED __builtin_amdgcn_sched_barrier(0)
    Unit cur, nxt; int ui = 0;
    if (!S.next(0, cur)) return;
    const LAS unsigned char* zlds = lds + (ZERO_OFF - RING_OFF);
    f32x4 acc[2][2][4][2];
#pragma unroll
    for (int a = 0; a < 2; ++a)
#pragma unroll
        for (int b = 0; b < 2; ++b)
#pragma unroll
            for (int m = 0; m < 4; ++m)
#pragma unroll
                for (int n = 0; n < 2; ++n) acc[a][b][m][n] = (f32x4){0.f, 0.f, 0.f, 0.f};
    bf16x8 At[4][2], B0[2][2], B1[2][2];
    v8i At8[4], B08[2], B18[2];
    int sc_w = 0x7A7A7A7A, sc_x = g.sx, sc_u = g.su; asm volatile("" : "+v"(sc_w), "+v"(sc_x), "+v"(sc_u));
    unsigned cofs[2][2], nofs[2][2];
#define PG8_ROWOFS(dst, pm_) do { int t_[2][2];                                    \
        _Pragma("unroll") for (int h_ = 0; h_ < 2; ++h_) _Pragma("unroll") for (int i_ = 0; i_ < 2; ++i_) { int R_, C_; stage_rc(tid * 16 + i_ * 8192, R_, C_); t_[h_][i_] = rowidx[(pm_) * BM + h_ * HALF + R_]; } \
        asm volatile("" ::: "memory"); \
        _Pragma("unroll") for (int h_ = 0; h_ < 2; ++h_) _Pragma("unroll") for (int i_ = 0; i_ < 2; ++i_) { int R_, C_; stage_rc(tid * 16 + i_ * 8192, R_, C_); \
        const int u_ = t_[h_][i_] < 0 ? 0 : t_[h_][i_]; dst[h_][i_] = (unsigned)u_ * (unsigned)rb + 2u * (unsigned)C_; } } while (0)
#define PG8_STAGE_A(bufoff, kb, h, ofs) do { if constexpr (GATHER) { PG8_STAGE(bufoff, (const char*)g.A + (kb), ofs); } else { PG8_STAGE(bufoff, (kb) + (h) * hstep, voffA); } } while (0)
    const char* cA = (const char*)g.A + (size_t)cur.pm * tstep; const char* cB = (const char*)g.Bt + (size_t)cur.pn * tstep;
    if constexpr (GATHER) { PG8_ROWOFS(cofs, cur.pm); }
    if constexpr (GATHER) {
        PG8_STAGE(PG8_SB(0, 0), cB, voffB); PG8_STAGE(PG8_SB(0, 1), cB + hstep, voffB); PG8_STAGE(PG8_SA(0, 0), (const char*)g.A, cofs[0]); PG8_STAGE(PG8_SA(0, 1), (const char*)g.A, cofs[1]);
    } else {
        PG8_STAGE(PG8_SB(0, 0), cB, voffB); PG8_STAGE(PG8_SB(0, 1), cB + hstep, voffB); PG8_STAGE(PG8_SA(0, 0), cA, voffA); PG8_STAGE(PG8_SA(0, 1), cA + hstep, voffA);
    }
    if (wr == 1) PG8_BAR;
    PG8_WAIT_V(2); PG8_BAR;
    if constexpr (GATHER) {
        PG8_STAGE(PG8_SB(1, 0), cB + kstep, voffB); PG8_STAGE(PG8_SA(1, 0), (const char*)g.A + kstep, cofs[0]); PG8_STAGE(PG8_SB(1, 1), cB + hstep + kstep, voffB);
    } else {
        PG8_STAGE(PG8_SB(1, 0), cB + kstep, voffB); PG8_STAGE(PG8_SA(1, 0), cA + kstep, voffA); PG8_STAGE(PG8_SB(1, 1), cB + hstep + kstep, voffB);
    }
    PG8_WAIT_V(6); PG8_BAR;
    for (;;) {
        const bool has_next = S.next(ui + 1, nxt);
        const char* nA = has_next ? (const char*)g.A + (size_t)nxt.pm * tstep : cA; const char* nB = has_next ? (const char*)g.Bt + (size_t)nxt.pn * tstep : cB;
        if constexpr (GATHER) { if (has_next) { PG8_ROWOFS(nofs, nxt.pm); } else { nofs[0][0] = cofs[0][0]; nofs[0][1] = cofs[0][1]; nofs[1][0] = cofs[1][0]; nofs[1][1] = cofs[1][1]; } }
        for (int t = 0; t < nt; t += 2) {
            const bool last = (t == nt - 2);
            const char* b2 = last ? nB : cB + (size_t)(t + 2) * kstep; const char* b3 = b2 + kstep;
            if constexpr (GATHER) {
                const size_t k1 = (size_t)(t + 1) * kstep, k2 = last ? (size_t)0 : (size_t)(t + 2) * kstep, k3 = k2 + kstep;
                unsigned o2h0[2], o2h1[2];
                o2h0[0] = last ? nofs[0][0] : cofs[0][0]; o2h0[1] = last ? nofs[0][1] : cofs[0][1]; o2h1[0] = last ? nofs[1][0] : cofs[1][0]; o2h1[1] = last ? nofs[1][1] : cofs[1][1];
                PG8_LDB(B0, 0, 0); PG8_LDB(B1, 0, 1); PG8_SCHED; PG8_LDA(At, 0, 0); PG8_STAGE(PG8_SA(1, 1), (const char*)g.A + k1, cofs[1]);
                PG8_WAIT_V(8); PG8_WAIT_L(0); PG8_BAR; PG8_MMA(0, 0, At, B0); PG8_MMA(0, 1, At, B1); PG8_BAR; PG8_SCHED;
                PG8_LDA(At, 0, 1); PG8_STAGE(PG8_SB(0, 0), b2, voffB); PG8_STAGE(PG8_SB(0, 1), b2 + hstep, voffB); PG8_STAGE(PG8_SA(0, 0), (const char*)g.A + k2, o2h0);
                PG8_WAIT_V(8); PG8_WAIT_L(0); PG8_BAR; PG8_MMA(1, 0, At, B0); PG8_MMA(1, 1, At, B1); PG8_BAR; PG8_SCHED;
                PG8_LDB(B0, 1, 0); PG8_LDB(B1, 1, 1); PG8_SCHED; PG8_LDA(At, 1, 0); PG8_STAGE(PG8_SA(0, 1), (const char*)g.A + k2, o2h1);
                PG8_WAIT_V(8); PG8_WAIT_L(0); PG8_BAR; PG8_MMA(0, 0, At, B0); PG8_MMA(0, 1, At, B1); PG8_BAR; PG8_SCHED;
                PG8_LDA(At, 1, 1); PG8_STAGE(PG8_SB(1, 0), b3, voffB); PG8_STAGE(PG8_SB(1, 1), b3 + hstep, voffB); PG8_STAGE(PG8_SA(1, 0), (const char*)g.A + k3, o2h0);
                PG8_WAIT_V(8); PG8_WAIT_L(0); PG8_BAR; PG8_MMA(1, 0, At, B0); PG8_MMA(1, 1, At, B1); PG8_BAR; PG8_SCHED;
            } else {
                const char* a1 = cA + (size_t)(t + 1) * kstep;
                const char* a2 = last ? nA : cA + (size_t)(t + 2) * kstep;
                const char* a3 = a2 + kstep;
                PG8_LDB(B0, 0, 0); PG8_LDB(B1, 0, 1); PG8_SCHED; PG8_LDA(At, 0, 0); PG8_STAGE(PG8_SA(1, 1), a1 + hstep, voffA);
                PG8_WAIT_V(8); PG8_WAIT_L(0); PG8_BAR; PG8_MMA(0, 0, At, B0); PG8_MMA(0, 1, At, B1); PG8_BAR; PG8_SCHED;
                PG8_LDA(At, 0, 1); PG8_STAGE(PG8_SB(0, 0), b2, voffB); PG8_STAGE(PG8_SB(0, 1), b2 + hstep, voffB); PG8_STAGE(PG8_SA(0, 0), a2, voffA);
                PG8_WAIT_V(8); PG8_WAIT_L(0); PG8_BAR; PG8_MMA(1, 0, At, B0); PG8_MMA(1, 1, At, B1); PG8_BAR; PG8_SCHED;
                PG8_LDB(B0, 1, 0); PG8_LDB(B1, 1, 1); PG8_SCHED; PG8_LDA(At, 1, 0); PG8_STAGE(PG8_SA(0, 1), a2 + hstep, voffA);
                PG8_WAIT_V(8); PG8_WAIT_L(0); PG8_BAR; PG8_MMA(0, 0, At, B0); PG8_MMA(0, 1, At, B1); PG8_BAR; PG8_SCHED;
                PG8_LDA(At, 1, 1); PG8_STAGE(PG8_SB(1, 0), b3, voffB); PG8_STAGE(PG8_SB(1, 1), b3 + hstep, voffB); PG8_STAGE(PG8_SA(1, 0), a3, voffA);
                PG8_WAIT_V(8); PG8_WAIT_L(0); PG8_BAR; PG8_MMA(1, 0, At, B0); PG8_MMA(1, 1, At, B1); PG8_BAR; PG8_SCHED;
            }
        }
        if constexpr (ALIGN_EPI) { if (wr == 0) PG8_BAR; }
        if constexpr (FP8) {
            asm volatile("s_nop 15\n\ts_nop 15"
                : "+v"(acc[1][0][0][0]), "+v"(acc[1][0][0][1]), "+v"(acc[1][0][1][0]), "+v"(acc[1][0][1][1]), "+v"(acc[1][0][2][0]), "+v"(acc[1][0][2][1]), "+v"(acc[1][0][3][0]), "+v"(acc[1][0][3][1]),
                  "+v"(acc[1][1][0][0]), "+v"(acc[1][1][0][1]), "+v"(acc[1][1][1][0]), "+v"(acc[1][1][1][1]), "+v"(acc[1][1][2][0]), "+v"(acc[1][1][2][1]), "+v"(acc[1][1][3][0]), "+v"(acc[1][1][3][1])); }
        E(acc, cur, wr, wc, fr, fq);
        if (!has_next) break;
        { int zo = 0; asm volatile("" : "+v"(zo));
          const LAS unsigned char* zp = zlds + zo;
#pragma unroll
          for (int a = 0; a < 2; ++a)
#pragma unroll
            for (int b = 0; b < 2; ++b)
#pragma unroll
                for (int m = 0; m < 4; ++m)
#pragma unroll
                    for (int n = 0; n < 2; ++n) acc[a][b][m][n] = *(const LAS f32x4*)(zp + (((a * 2 + b) * 4 + m) * 2 + n) * 16); }
        cur = nxt; cA = nA; cB = nB; ++ui;
        if constexpr (GATHER) { cofs[0][0] = nofs[0][0]; cofs[0][1] = nofs[0][1]; cofs[1][0] = nofs[1][0]; cofs[1][1] = nofs[1][1]; }
        if constexpr (ALIGN_EPI) { if (wr == 1) PG8_BAR; }
    }
    PG8_WAIT_V(0);
    if constexpr (!ALIGN_EPI) { if (wr == 0) PG8_BAR; }
    PG8_BAR;
#undef PG8_STAGE_A
#undef PG8_ROWOFS
#undef PG8_SA
#undef PG8_SB
#undef PG8_STAGE
#undef PG8_LDA
#undef PG8_LDB
#undef PG8_MMA
#undef PG8_WAIT_V
#undef PG8_WAIT_L
#undef PG8_BAR
#undef PG8_SCHED
}

typedef const f32x4 (&AccRef)[2][2][4][2];
__device__ __forceinline__ float row_rstd(const float* ssq, int row) {
    const f32x4* p = (const f32x4*)(ssq + (size_t)row * 16); const f32x4 a = p[0], b = p[1], c = p[2], d = p[3];
    const float s = (((a.x + a.y) + (a.z + a.w)) + ((b.x + b.y) + (b.z + b.w))) + (((c.x + c.y) + (c.z + c.w)) + ((d.x + d.y) + (d.z + d.w)));
    return 1.f / sqrtf(s * (1.f / DM) + NORM_EPS);
}
__device__ __forceinline__ void rows_rstd(const float* ssq, int row0, int fq, float (&rs)[8]) {
    f32x4 p[8];
#pragma unroll
    for (int i = 0; i < 8; ++i) p[i] = *(const f32x4*)(ssq + (size_t)(row0 + (i >> 2) * HALF + (i & 3) * 16) * 16 + 4 * fq);
    asm volatile("" ::: "memory");
#pragma unroll
    for (int i = 0; i < 8; ++i) { float s = (p[i].x + p[i].y) + (p[i].z + p[i].w); s = xor32_sum(xor16_sum(s)); rs[i] = __builtin_amdgcn_rsqf(s * (1.f / DM) + NORM_EPS); }
}
struct EpiProj {
    bf16_t* Q; unsigned char* KT; unsigned char* VT; const float* ssq;
    __device__ __forceinline__ void operator()(AccRef acc, const Unit& u, int wr, int wc, int fr, int fq) const {
        const int row0 = u.pm * BM + wr * 64 + fr, colt = wc * 32 + 8 * fq;
        const int pn = u.pn, sect = pn >> 1;
        const int kind = sect % 3, gbase = sect >= 3 ? 4 : 0, c0 = (pn & 1) * 256 + colt;
        float rsv[8]; rows_rstd(ssq, row0, fq, rsv);
        auto body = [&](auto kind_tag) __attribute__((always_inline)) {
            constexpr int KIND = decltype(kind_tag)::value;
            const float sc = KIND == 0 ? C2 : 1.f;
#pragma unroll
            for (int ai = 0; ai < 2; ++ai)
#pragma unroll
                for (int m = 0; m < 4; ++m) { const int row = row0 + ai * HALF + m * 16; const int bT = row >> 6, key = row & 63;
                    const float rs = sc * rsv[ai * 4 + m];
#pragma unroll
                    for (int bj = 0; bj < 2; ++bj) { const f32x4 v0 = acc[ai][bj][m][0] * rs, v1 = acc[ai][bj][m][1] * rs;
                        u32x4 w; w.x = cvt_pk_bf16(v0[0], v0[1]); w.y = cvt_pk_bf16(v0[2], v0[3]); w.z = cvt_pk_bf16(v1[0], v1[1]); w.w = cvt_pk_bf16(v1[2], v1[3]);
                        const int cc = c0 + bj * HALF;
                        if constexpr (KIND == 0) *(u32x4*)(Q + (size_t)row * DM + (gbase ? 512 : 0) + cc) = w;
                        else if constexpr (KIND == 1) *(u32x4*)(KT + ((size_t)(((bT * 8 + gbase + (cc >> 7)) * 2 + ((cc >> 6) & 1)) * 8 + ((cc >> 3) & 7)) << 10) + key * 16) = w;
                        else *(u32x4*)(VT + ((size_t)(bT * 8 + gbase + (cc >> 7)) << 14) + (((cc & 127) >> 5) << 12) + key * 64 + (cc & 31) * 2) = w; } }
        };
        if (kind == 0) body(std::integral_constant<int, 0>{}); else if (kind == 1) body(std::integral_constant<int, 1>{}); else body(std::integral_constant<int, 2>{});
    }
};
template <bool A8 = false>
struct EpiRes {
    bf16_t* X; float* ssq; unsigned char* a8 = nullptr;
    __device__ __forceinline__ void operator()(AccRef acc, const Unit& u, int wr, int wc, int fr, int fq) const {
        const int row0 = u.pm * BM + wr * 64 + fr, col0 = u.pn * BM + wc * 32 + 8 * fq;
#pragma unroll
        for (int ai = 0; ai < 2; ++ai) {
        u32x4 xr[4][2];
#pragma unroll
            for (int m = 0; m < 4; ++m)
#pragma unroll
                for (int bj = 0; bj < 2; ++bj) xr[m][bj] = *(const u32x4*)(X + (size_t)(row0 + ai * HALF + m * 16) * DM + col0 + bj * HALF);
        asm volatile("" ::: "memory");
#pragma unroll
            for (int m = 0; m < 4; ++m) { const int row = row0 + ai * HALF + m * 16; const size_t off = (size_t)row * DM + col0; float sq = 0.f;
#pragma unroll
                for (int bj = 0; bj < 2; ++bj) { const u32x4 r = xr[m][bj];
                    const f32x4 x0 = f32x4{bf_lo(r.x), bf_hi(r.x), bf_lo(r.y), bf_hi(r.y)} + acc[ai][bj][m][0], x1 = f32x4{bf_lo(r.z), bf_hi(r.z), bf_lo(r.w), bf_hi(r.w)} + acc[ai][bj][m][1];
                    u32x4 w; w.x = cvt_pk_bf16(x0[0], x0[1]); w.y = cvt_pk_bf16(x0[2], x0[3]); w.z = cvt_pk_bf16(x1[0], x1[1]); w.w = cvt_pk_bf16(x1[2], x1[3]);
                    *(u32x4*)(X + off + bj * HALF) = w;
                    if constexpr (A8) { u32x2 w8; w8.x = pk4_fp8(8.f * x0[0], 8.f * x0[1], 8.f * x0[2], 8.f * x0[3]); w8.y = pk4_fp8(8.f * x1[0], 8.f * x1[1], 8.f * x1[2], 8.f * x1[3]); *(u32x2*)(a8 + off + bj * HALF) = w8; }
                    sq += ((x0.x * x0.x + x0.y * x0.y) + (x0.z * x0.z + x0.w * x0.w)) + ((x1.x * x1.x + x1.y * x1.y) + (x1.z * x1.z + x1.w * x1.w)); }
                sq = xor32_sum(xor16_sum(sq));
                if (fq == 0) ssq[(size_t)row * 16 + u.pn * 4 + wc] = sq; }
        asm volatile("" ::: "memory");
        }
    }
};
__device__ __forceinline__ float silu_mul(float gp, float up) { return gp * up * __builtin_amdgcn_rcpf(1.f + __builtin_amdgcn_exp2f(gp)); }
template <bool NORM, bool F8>
struct EpiSwiGLU {
    bf16_t* H; int ldh; int nnl; const float* ssq;
    __device__ __forceinline__ void operator()(AccRef acc, const Unit& u, int wr, int wc, int fr, int fq) const {
        const int row0 = u.pm * BM + wr * 64 + fr, col0 = (u.pn % nnl) * HALF + wc * 32 + 8 * fq;
        float rsv[8];
        if constexpr (NORM) rows_rstd(ssq, row0, fq, rsv);
#pragma unroll
        for (int ai = 0; ai < 2; ++ai)
#pragma unroll
            for (int m = 0; m < 4; ++m) { bf16_t* rowp = H + (size_t)(row0 + ai * HALF + m * 16) * ldh + col0;
                f32x4 g0 = acc[ai][0][m][0], g1 = acc[ai][0][m][1], u0 = acc[ai][1][m][0], u1 = acc[ai][1][m][1];
                if constexpr (NORM) { const float rs = rsv[ai * 4 + m], ru = F8 ? 8.f * rs : rs; g0 = g0 * rs; g1 = g1 * rs; u0 = u0 * ru; u1 = u1 * ru; }
                const float h0 = silu_mul(g0[0], u0[0]), h1 = silu_mul(g0[1], u0[1]), h2 = silu_mul(g0[2], u0[2]), h3 = silu_mul(g0[3], u0[3]), h4 = silu_mul(g1[0], u1[0]), h5 = silu_mul(g1[1], u1[1]), h6 = silu_mul(g1[2], u1[2]), h7 = silu_mul(g1[3], u1[3]);
                if constexpr (F8) { u32x2 w8; w8.x = pk4_fp8(h0, h1, h2, h3); w8.y = pk4_fp8(h4, h5, h6, h7);
                    *(u32x2*)((unsigned char*)H + (size_t)(row0 + ai * HALF + m * 16) * ldh + col0) = w8; }
                else { u32x4 w; w.x = cvt_pk_bf16(h0, h1); w.y = cvt_pk_bf16(h2, h3); w.z = cvt_pk_bf16(h4, h5); w.w = cvt_pk_bf16(h6, h7);
                    *(u32x4*)rowp = w; } }
    }
};
struct EpiMoeDown {
    bf16_t* X; const int* rtok; const float* rgate; float gsc;
    __device__ __forceinline__ void operator()(AccRef acc, const Unit& u, int wr, int wc, int fr, int fq) const {
        const int row0 = u.pm * BM + wr * 64 + fr, col0 = (u.pn & 3) * BM + wc * 32 + 8 * fq;
        int tk[8]; float gv[8];
#pragma unroll
        for (int i = 0; i < 8; ++i) { const int r = row0 + (i >> 2) * HALF + (i & 3) * 16; tk[i] = rtok[r]; gv[i] = rgate[r]; }
        asm volatile("" ::: "memory");
        u32x4 xr[8][2];
#pragma unroll
        for (int i = 0; i < 8; ++i) { const bf16_t* xq = X + (size_t)(tk[i] < 0 ? 0 : tk[i]) * DM + col0;
            xr[i][0] = *(const u32x4*)xq; xr[i][1] = *(const u32x4*)(xq + HALF); }
        asm volatile("" ::: "memory");
        __builtin_amdgcn_s_waitcnt(0x0F70);
#pragma unroll
        for (int ai = 0; ai < 2; ++ai)
#pragma unroll
            for (int m = 0; m < 4; ++m) { const int tok = tk[ai * 4 + m]; const float gt = gv[ai * 4 + m] * gsc;
                if (tok >= 0) { bf16_t* xp = X + (size_t)tok * DM + col0;
#pragma unroll
                    for (int bj = 0; bj < 2; ++bj) { const u32x4 r = xr[ai * 4 + m][bj];
                        const f32x4 x0 = f32x4{bf_lo(r.x), bf_hi(r.x), bf_lo(r.y), bf_hi(r.y)} + acc[ai][bj][m][0] * gt, x1 = f32x4{bf_lo(r.z), bf_hi(r.z), bf_lo(r.w), bf_hi(r.w)} + acc[ai][bj][m][1] * gt;
                        u32x4 w; w.x = cvt_pk_bf16(x0[0], x0[1]); w.y = cvt_pk_bf16(x0[2], x0[3]); w.z = cvt_pk_bf16(x1[0], x1[1]); w.w = cvt_pk_bf16(x1[2], x1[3]);
                        *(u32x4*)(xp + bj * HALF) = w; } } }
    }
};
}

#define XB_TMO      128
#define XB_XCNT(j)  (256  + 64 * (j))
#define XB_XSUB(j)  (1280 + 64 * (j))
#define XB_XGEN(j)  (2304 + 64 * (j))
#define XB_TOP      3328
#define XB_TOPGEN   3392
#define XCD_BAR_WORDS 3456
static_assert((size_t)(CW_BAR + XCD_BAR_WORDS) * 4 <= CTL_ZERO_BYTES, "the per-call memset covers every control word");
#define XB_SPIN_CAP (1u << 20)

__device__ __forceinline__ unsigned xb_ld(unsigned* p)              { return __hip_atomic_load(p, __ATOMIC_RELAXED, __HIP_MEMORY_SCOPE_AGENT); }
__device__ __forceinline__ unsigned xb_add(unsigned* p, unsigned v) { return __hip_atomic_fetch_add(p, v, __ATOMIC_RELAXED, __HIP_MEMORY_SCOPE_AGENT); }
__device__ __forceinline__ unsigned xb_xcc_id() { return (unsigned)__builtin_amdgcn_s_getreg((3 << 11) | 20) & 0xFu; }
#define XB_SPIN(cond, bar) do { unsigned _sp = 0; while (cond) { __builtin_amdgcn_s_sleep(1); \
    if ((++_sp & 255u) == 0u) { if (xb_ld(&(bar)[XB_TMO])) break; if (_sp > XB_SPIN_CAP) { atomicAdd(&(bar)[XB_TMO], 1u); break; } } } } while (0)

struct XcdBarrier { unsigned* bar; unsigned x; volatile LAS unsigned* st; };

__device__ __forceinline__ XcdBarrier xcd_barrier_post(unsigned* bar, volatile LAS unsigned* st) {
    XcdBarrier b; b.bar = bar; b.x = xb_xcc_id(); b.st = st;
    if (threadIdx.x == 0) (void)xb_add(&bar[XB_XCNT(b.x)], 1u);
    return b;
}
__device__ __forceinline__ void xcd_barrier_complete(unsigned* bar, unsigned x, unsigned& nloc, unsigned& nx) {
    const unsigned G = gridDim.x * gridDim.y * gridDim.z;
    unsigned sum, cnt, mine, sp = 0u;
    for (;;) {
        sum = 0u; cnt = 0u; mine = 0u;
#pragma unroll
        for (unsigned j = 0; j < 16; ++j) { const unsigned c = xb_ld(&bar[XB_XCNT(j)]); sum += c; cnt += (c > 0u) ? 1u : 0u; mine = (j == x) ? c : mine; }
        if (sum == G) break;
        __builtin_amdgcn_s_sleep(1);
        if ((++sp & 255u) == 0u) { if (xb_ld(&bar[XB_TMO])) break; if (sp > XB_SPIN_CAP) { atomicAdd(&bar[XB_TMO], 1u); break; } }
    }
    nloc = mine > 0u ? mine : 1u; nx = cnt > 0u ? cnt : 1u;
}
__device__ __forceinline__ void xcd_barrier(const XcdBarrier& b) {
    asm volatile("s_waitcnt vmcnt(0)" ::: "memory");
    __syncthreads();
    if (threadIdx.x == 0) {
        unsigned* bar = b.bar;
        __builtin_amdgcn_s_waitcnt(0);
        unsigned nloc = b.st[0], nx = b.st[1];
        if (nloc == 0u) { xcd_barrier_complete(bar, b.x, nloc, nx); b.st[0] = nloc; b.st[1] = nx; }
        const unsigned old = xb_add(&bar[XB_XSUB(b.x)], 1u);
        const unsigned gen = old / nloc;
        if (old + 1u == (gen + 1u) * nloc) {
            __builtin_amdgcn_fence(__ATOMIC_RELEASE, "agent");
            asm volatile("s_waitcnt vmcnt(0)" ::: "memory");
            const unsigned og = xb_add(&bar[XB_TOP], 1u);
            const unsigned tg = og / nx;
            if (og + 1u == (tg + 1u) * nx) xb_add(&bar[XB_TOPGEN], 1u);
            else XB_SPIN(xb_ld(&bar[XB_TOPGEN]) == tg, bar);
            __builtin_amdgcn_fence(__ATOMIC_ACQUIRE, "agent");
            xb_add(&bar[XB_XGEN(b.x)], 1u);
            asm volatile("s_waitcnt vmcnt(0)" ::: "memory");
        } else {
            XB_SPIN(xb_ld(&bar[XB_XGEN(b.x)]) == gen, bar);
            __builtin_amdgcn_fence(__ATOMIC_ACQUIRE, "agent");
            asm volatile("s_waitcnt vmcnt(0)" ::: "memory");
        }
    }
    __syncthreads();
}

__device__ __forceinline__ void transpose_item(const float* W, int N, bf16_t* WT, int ldk, int dst_row0, LAS float* scr, int k0, int n0, int lane, const float* kgain, float ws) {
    f32x4 v[8];
    const float* src = W + (size_t)(k0 + (lane >> 3)) * N + n0 + (lane & 7) * 4;
#pragma unroll
    for (int i = 0; i < 8; ++i) v[i] = __builtin_nontemporal_load((const GAS f32x4*)(src + (size_t)(8 * i) * N));
#pragma unroll
    for (int i = 0; i < 8; ++i) { LAS float* d = scr + (8 * i + (lane >> 3)) * 33 + (lane & 7) * 4; d[0] = v[i].x; d[1] = v[i].y; d[2] = v[i].z; d[3] = v[i].w; }
    LDS_WAIT(); asm volatile("" ::: "memory");
    const int c = lane & 7;
    f32x4 ga = {ws, ws, ws, ws}, gb = ga;
    if (kgain) { ga = *(const f32x4*)(kgain + k0 + 8 * c) * ws; gb = *(const f32x4*)(kgain + k0 + 8 * c + 4) * ws; }
#pragma unroll
    for (int j = 0; j < 4; ++j) { const int n = (lane >> 3) + 8 * j; const LAS float* s = scr + (8 * c) * 33 + n;
        u32x4 o; o.x = pk2(s[0 * 33] * ga.x, s[1 * 33] * ga.y); o.y = pk2(s[2 * 33] * ga.z, s[3 * 33] * ga.w); o.z = pk2(s[4 * 33] * gb.x, s[5 * 33] * gb.y); o.w = pk2(s[6 * 33] * gb.z, s[7 * 33] * gb.w);
        *(GAS u32x4*)(WT + (size_t)(dst_row0 + n) * ldk + k0 + 8 * c) = o; }
    LDS_WAIT(); asm volatile("" ::: "memory");
}
__device__ __forceinline__ void transpose_item8(const float* W, int N, unsigned char* WT, int ldk, int dst_row0, LAS float* scr, int k0, int n0, int lane, float wscale, const float* kgain) {
    f32x4 v[16];
    const float* src = W + (size_t)(k0 + (lane >> 3)) * N + n0 + (lane & 7) * 4;
#pragma unroll
    for (int i = 0; i < 16; ++i) v[i] = __builtin_nontemporal_load((const GAS f32x4*)(src + (size_t)(8 * i) * N));
    const int c = lane & 7;
#pragma unroll
    for (int h = 0; h < 2; ++h) {
#pragma unroll
        for (int i = 0; i < 8; ++i) { LAS float* d = scr + (8 * i + (lane >> 3)) * 33 + (lane & 7) * 4; d[0] = v[8 * h + i].x; d[1] = v[8 * h + i].y; d[2] = v[8 * h + i].z; d[3] = v[8 * h + i].w; }
        LDS_WAIT(); asm volatile("" ::: "memory");
        f32x4 ga = {wscale, wscale, wscale, wscale}, gb = ga;
        if (kgain) { ga = *(const f32x4*)(kgain + k0 + 64 * h + 8 * c) * wscale; gb = *(const f32x4*)(kgain + k0 + 64 * h + 8 * c + 4) * wscale; }
#pragma unroll
        for (int j = 0; j < 4; ++j) { const int n = (lane >> 3) + 8 * j; const LAS float* s = scr + (8 * c) * 33 + n;
            u32x2 o; o.x = pk4_fp8(s[0 * 33] * ga.x, s[1 * 33] * ga.y, s[2 * 33] * ga.z, s[3 * 33] * ga.w); o.y = pk4_fp8(s[4 * 33] * gb.x, s[5 * 33] * gb.y, s[6 * 33] * gb.z, s[7 * 33] * gb.w);
            *(GAS u32x2*)(WT + (size_t)(dst_row0 + n) * ldk + k0 + 64 * h + 8 * c) = o; }
        LDS_WAIT(); asm volatile("" ::: "memory");
    }
}
__device__ __forceinline__ void transpose_matrix8(const float* W, int K, int N, unsigned char* WT, bool inter, int inter_off, LAS float* scr, int gw, int NGW, int lane, float wscale, int rot, const float* kgain = nullptr) {
    const int nblk = N / 32, items = (K / 128) * nblk;
    int w0 = gw - rot % NGW; if (w0 < 0) w0 += NGW;
    for (int it = w0; it < items; it += NGW) { const int kb = it / nblk, nb = it % nblk, n0 = 32 * nb;
        const int dr = inter ? ((n0 >> 7) * 256 + (n0 & 127) + inter_off) : n0;
        transpose_item8(W, N, WT, K, dr, scr, 128 * kb, n0, lane, wscale, kgain); }
}
__device__ __forceinline__ void transpose_matrix(const float* W, int K, int N, bf16_t* WT, bool inter, int inter_off, LAS float* scr, int gw, int NGW, int lane, const float* kgain, int rot, float ws = 1.f) {
    const int nblk = N / 32, items = (K / 64) * nblk;
    int w0 = gw - rot % NGW; if (w0 < 0) w0 += NGW;
    for (int it = w0; it < items; it += NGW) { const int kb = it / nblk, nb = it % nblk, n0 = 32 * nb;
        const int dr = inter ? ((n0 >> 7) * 256 + (n0 & 127) + inter_off) : n0;
        transpose_item(W, N, WT, K, dr, scr, 64 * kb, n0, lane, kgain, ws); }
}
__device__ __forceinline__ void load_row(const float* xrow, int lane, f32x4 (&v)[4]) {
    const GAS f32x4* xr = (const GAS f32x4*)xrow + lane;
#pragma unroll
    for (int j = 0; j < 4; ++j) v[j] = __builtin_nontemporal_load(xr + 64 * j);
}
template <bool NT = false>
__device__ __forceinline__ void load_row_bf(const bf16_t* xrow, int lane, u32x2 (&r)[4]) {
    const GAS u32x2* xr = (const GAS u32x2*)xrow + lane;
#pragma unroll
    for (int j = 0; j < 4; ++j) r[j] = NT ? __builtin_nontemporal_load(xr + 64 * j) : xr[64 * j];
}
__device__ __forceinline__ void cvt_row(const u32x2 (&r)[4], f32x4 (&v)[4]) {
#pragma unroll
    for (int j = 0; j < 4; ++j) v[j] = f32x4{bf_lo(r[j].x), bf_hi(r[j].x), bf_lo(r[j].y), bf_hi(r[j].y)};
}
__device__ __forceinline__ void norm_row(const float* g, int lane, f32x4 (&v)[4]) {
    asm volatile("" : "+s"(g));
    const GAS f32x4* gr = (const GAS f32x4*)g + lane;
    float s2 = 0.f;
#pragma unroll
    for (int j = 0; j < 4; ++j) s2 += (v[j].x * v[j].x + v[j].y * v[j].y) + (v[j].z * v[j].z + v[j].w * v[j].w);
    const float rstd = __builtin_amdgcn_rsqf(wave_sum(s2) * (1.f / DM) + NORM_EPS);
#pragma unroll
    for (int j = 0; j < 4; ++j) v[j] = v[j] * rstd * gr[64 * j];
}
__device__ __forceinline__ void norm_row_l(const LAS float* gl, int lane, f32x4 (&v)[4]) {
    const LAS f32x4* gr = (const LAS f32x4*)gl + lane;
    f32x4 gg[4];
#pragma unroll
    for (int j = 0; j < 4; ++j) gg[j] = gr[64 * j];
    float s2 = 0.f;
#pragma unroll
    for (int j = 0; j < 4; ++j) s2 += (v[j].x * v[j].x + v[j].y * v[j].y) + (v[j].z * v[j].z + v[j].w * v[j].w);
    const float rstd = __builtin_amdgcn_rsqf(wave_sum(s2) * (1.f / DM) + NORM_EPS);
#pragma unroll
    for (int j = 0; j < 4; ++j) v[j] = v[j] * rstd * gg[j];
}
__device__ __forceinline__ void rms_row(const float* xrow, const float* g, int lane, f32x4 (&v)[4]) { load_row(xrow, lane, v); norm_row(g, lane, v); }
__device__ __forceinline__ void store_row_bf16(bf16_t* orow, int lane, const f32x4 (&v)[4]) {
    GAS unsigned long long* o8 = (GAS unsigned long long*)orow + lane;
#pragma unroll
    for (int j = 0; j < 4; ++j) o8[64 * j] = (unsigned long long)pk2(v[j].x, v[j].y) | ((unsigned long long)pk2(v[j].z, v[j].w) << 32);
}

namespace att {
constexpr int BUFB = 32768, KIMG = 8192, VOFF = 16384;
constexpr int SCR_OFF = 3 * BUFB, FLAG_OFF = SCR_OFF + NWAVES * 256;
constexpr float THR = 8.f, SB_DONE = 7.5e-37f;
#ifndef ATT_LS_DIFF
#define ATT_LS_DIFF 1
#endif
#ifndef ATT_LS_SB
#define ATT_LS_SB 1
#endif
__device__ __forceinline__ int crow(int r, int hi) { return (r & 3) + 8 * (r >> 2) + 4 * hi; }
__device__ __forceinline__ f32x16 mfma32(bf16x8 a, bf16x8 b, f32x16 c) { return __builtin_amdgcn_mfma_f32_32x32x16_bf16(a, b, c, 0, 0, 0); }
typedef short v4i16_t __attribute__((ext_vector_type(4)));
__device__ __forceinline__ s16x4 vtr(const LAS unsigned char* p) { return __builtin_bit_cast(s16x4, __builtin_amdgcn_ds_read_tr16_b64_v4i16((LAS v4i16_t*)p)); }
__device__ __forceinline__ float max3f(float a, float b, float c) { return __builtin_fmaxf(__builtin_fmaxf(a, b), c); }
__device__ __forceinline__ unsigned cvtpk(float lo, float hi) { f32x2_t v = {lo, hi}; bf16x2_t b = __builtin_convertvector(v, bf16x2_t); return __builtin_bit_cast(unsigned, b); }
__device__ __forceinline__ float swap_max(float v) { auto rr = __builtin_amdgcn_permlane32_swap(__float_as_uint(v), __float_as_uint(v), false, false); return fmaxf(__uint_as_float(rr[0]), __uint_as_float(rr[1])); }
__device__ __forceinline__ float swap_sum(float v) { auto rr = __builtin_amdgcn_permlane32_swap(__float_as_uint(v), __float_as_uint(v), false, false); return __uint_as_float(rr[0]) + __uint_as_float(rr[1]); }

struct Params {
    const bf16_t* q; const unsigned char* kt; const unsigned char* vt; bf16_t* y;
    int goff;
    float lam, outscale;
};

#ifndef ATT_DMA_BUILTIN
#define ATT_DMA_BUILTIN 0
#endif
__device__ __forceinline__ void glds16(const void* gsrc, unsigned lds_dst) {
#if ATT_DMA_BUILTIN
    __builtin_amdgcn_global_load_lds((const unsigned*)gsrc, (LAS unsigned*)(uintptr_t)lds_dst, 16, 0, 0);
#else
    unsigned keep;
    asm volatile("s_mov_b32 %0, m0\n\ts_mov_b32 m0, %2\n\ts_nop 0\n\tglobal_load_lds_dwordx4 %1, off\n\ts_mov_b32 m0, %0" : "=&s"(keep) : "v"(gsrc), "s"(lds_dst) : "memory");
#endif
}

template <bool SBM>
__device__ __forceinline__ void unit(LAS unsigned char* lds, const Params& P, int b, int p, int qb, const int tid_in, bf16x8 (&qr)[4], const bool first, const bool has_next, const int nb, const int np, const int nqb) {
    int tid = tid_in; asm volatile("" : "+v"(tid));
    const int lane = tid & 63, r32 = lane & 31, hi = lane >> 5;
    const int wid = __builtin_amdgcn_readfirstlane(tid >> 6), c = wid >> 2, wq = wid & 3;
    const int q0 = qb * 128, qw = q0 + 32 * wq;
    const size_t rowbase = (size_t)b * SEQ;
    constexpr bool LS = SBM ? (ATT_LS_SB != 0) : (ATT_LS_DIFF != 0);
    static_assert(LS, "the tile loop reads V(j) at the start of X(j): only the lockstep schedule has it landed by then");
    const int qcol = (SBM ? 0 : 512) + p * 128 + c * 64, grp = (SBM ? 0 : 4) + p;
    constexpr int NB = SBM ? 2 : 4;
    LAS float* scr = (LAS float*)(lds + SCR_OFF) + wid * 64;
    volatile LAS int* flags = (volatile LAS int*)(lds + FLAG_OFF);
    const LAS float* tbl = (const LAS float*)(lds + TBL_OFF) + p * 132;
    const int NT = 2 * qb + 2;
    const unsigned char* kg = P.kt + ((size_t)((b * 64) * 8 + grp) << 14) + wid * 1024 + lane * 16;
    const unsigned char* vg = P.vt + ((size_t)((b * 64) * 8 + grp) << 14) + wid * 1024 + lane * 16;
    const unsigned lds0 = (unsigned)(uintptr_t)lds + (unsigned)wid * 1024u;
#define ATT_DMA_K(j_, b_) do { const size_t ro_ = (size_t)(NT - 1 - (j_)) << 17; const unsigned bo_ = lds0 + (unsigned)((b_) * BUFB); \
        glds16(kg + ro_, (unsigned)__builtin_amdgcn_readfirstlane(bo_)); glds16(kg + ro_ + 8192, (unsigned)__builtin_amdgcn_readfirstlane(bo_ + KIMG)); } while (0)
#define ATT_DMA_V(j_, b_) do { const size_t ro_ = (size_t)(NT - 1 - (j_)) << 17; const unsigned bo_ = lds0 + (unsigned)((b_) * BUFB + VOFF); \
        glds16(vg + ro_, (unsigned)__builtin_amdgcn_readfirstlane(bo_)); glds16(vg + ro_ + 8192, (unsigned)__builtin_amdgcn_readfirstlane(bo_ + 8192)); } while (0)
    if (first) { ATT_DMA_K(0, 0); ATT_DMA_V(0, 0);
      const bf16_t* qg = P.q + (rowbase + qw + r32) * DM + qcol + hi * 8;
#pragma unroll
      for (int d0 = 0; d0 < 4; ++d0) qr[d0] = *(const GAS bf16x8*)(qg + d0 * 16); }
    if (tid < 2 * NWAVES) flags[tid] = 0;
#pragma unroll
    for (int d0 = 0; d0 < 4; ++d0) asm volatile("" : "+v"(qr[d0]));
    asm volatile("s_waitcnt vmcnt(0) lgkmcnt(0)\n\ts_barrier" ::: "memory");
    ATT_DMA_K(1, 1); ATT_DMA_V(1, 1);
    f32x16 o[NB];
#pragma unroll
    for (int d = 0; d < NB; ++d) o[d] = f32x16{};
    float mref = 0.f, carry = 1.f; bool done = false, pend = false, fresh = true;
    f32x16 cc0 = f32x16{}, cc1 = f32x16{};
    f32x16 osum = f32x16{};
    u32x4 pw[4];
#pragma unroll
    for (int i = 0; i < 4; ++i) pw[i] = (u32x4){0u, 0u, 0u, 0u};
    s16x4 va[8];
#pragma unroll
    for (int i = 0; i < 8; ++i) va[i] = (s16x4){0, 0, 0, 0};
    const int vlane = ((lane >> 4) & 1) * 32 + (lane & 3) * 8 + (4 * hi + ((lane & 15) >> 2)) * 64 + (SBM ? c * 2 * 4096 : 0);
#define ATT_BAR(issued_) do { if (issued_) asm volatile("s_waitcnt vmcnt(4) lgkmcnt(0)\n\ts_barrier" ::: "memory"); else asm volatile("s_waitcnt vmcnt(0) lgkmcnt(0)\n\ts_barrier" ::: "memory"); } while (0)
#define ATT_FLAG_SET(h_) do { if constexpr (SBM) { if (lane == 0) flags[((h_) & 1) * NWAVES + wid] = (lastslot || done) ? 1 : 0; } } while (0)
#define ATT_FLAG_ALL(h_, res_) do { res_ = 0; if constexpr (SBM) { typedef int fl4_t __attribute__((ext_vector_type(4)));        \
        const LAS fl4_t* fp_ = (const LAS fl4_t*)(lds + FLAG_OFF) + ((h_) & 1) * 2; const fl4_t fa_ = fp_[0], fb_ = fp_[1]; const fl4_t fc_ = fa_ & fb_; res_ = (fc_.x & fc_.y) & (fc_.z & fc_.w); } } while (0)
    if (c == 1) __builtin_amdgcn_s_setprio(1);
    int b0 = 0;
    for (int j = 0; j < NT; ++j) {
        const int kt = NT - 1 - j, bo = b0 * BUFB, k0 = kt * 64, b2 = (b0 == 0) ? 2 : b0 - 1;
        const bool ahead = (j + 2 < NT);
        { if (ahead) { ATT_DMA_K(j + 2, b2); ATT_DMA_V(j + 2, b2); }
          pend = false;
          if (!done && k0 <= qw + 31) {
            pend = true;
            const LAS unsigned char* Kimg = lds + bo + c * KIMG + hi * 1024 + (r32 << 4);
            bf16x8 kf[8];
#pragma unroll
            for (int d0 = 0; d0 < 4; ++d0) { kf[2 * d0] = *(const LAS bf16x8*)(Kimg + d0 * 2048); kf[2 * d0 + 1] = *(const LAS bf16x8*)(Kimg + d0 * 2048 + 512); }
            { const LAS unsigned char* vb0 = lds + bo + VOFF + vlane;
              if constexpr (SBM) {
#pragma unroll
                for (int ks = 0; ks < 4; ++ks) { va[2 * ks] = vtr(vb0 + ks * 1024); va[2 * ks + 1] = vtr(vb0 + ks * 1024 + 512); }
              } }
            __builtin_amdgcn_sched_barrier(0);
            const int rel = qw + r32 - k0 - 4 * hi;
            f32x16 p0, p1;
            bool farb = false;
            if constexpr (!SBM) farb = (qw - (k0 + 63) >= 128);
            if constexpr (SBM) {
#pragma unroll
                for (int r = 0; r < 16; ++r) { p0[r] = 0.f; p1[r] = 0.f; }
#pragma unroll
                for (int d0 = 0; d0 < 4; ++d0) { p0 = mfma32(kf[2 * d0], qr[d0], p0); p1 = mfma32(kf[2 * d0 + 1], qr[d0], p1); }
            } else {
                if (!farb) {
                    const bool dmask = (k0 + 63 > qw);
                    const int sh = (227 - rel) & 3;
                    const LAS float* bt = (const LAS float*)(lds + BT_OFF) + (p * 4 + sh) * BT_N + (227 - rel - sh);
                    f32x4 rd[8];
#pragma unroll
                    for (int g = 0; g < 4; ++g) { rd[g] = *(const LAS f32x4*)(bt + 8 * g); rd[4 + g] = *(const LAS f32x4*)(bt + 32 + 8 * g); }
                    asm volatile("" ::: "memory");
                    const float nm = -mref;
                    if (dmask) {
#pragma unroll
                        for (int r = 0; r < 16; ++r) { const int kk = (r & 3) + 8 * (r >> 2);
                            cc0[r] = (rel - kk < 0) ? -INFINITY : nm + rd[r >> 2][r & 3]; cc1[r] = (rel - kk - 32 < 0) ? -INFINITY : nm + rd[4 + (r >> 2)][r & 3]; }
                    } else {
#pragma unroll
                        for (int r = 0; r < 16; ++r) { cc0[r] = nm + rd[r >> 2][r & 3]; cc1[r] = nm + rd[4 + (r >> 2)][r & 3]; }
                    }
                }
                p0 = mfma32(kf[0], qr[0], cc0); p1 = mfma32(kf[1], qr[0], cc1);
#pragma unroll
                for (int d0 = 1; d0 < 4; ++d0) { p0 = mfma32(kf[2 * d0], qr[d0], p0); p1 = mfma32(kf[2 * d0 + 1], qr[d0], p1); }
                if (!farb) { const float nm = -mref;
#pragma unroll
                    for (int r = 0; r < 16; ++r) { cc0[r] = nm; cc1[r] = nm; } }
            }
            __builtin_amdgcn_sched_barrier(0);
            if constexpr (SBM) {
                const bool needmask = (k0 + 63 >= qw);
                auto sb_weights = [&](auto mask_tag) __attribute__((always_inline)) {
                    constexpr bool MASK = decltype(mask_tag)::value;
                    float r0[16], r1[16];
#pragma unroll
                    for (int r = 0; r < 16; ++r) { const int kk = (r & 3) + 8 * (r >> 2);
                        const float e0 = __builtin_amdgcn_exp2f(p0[r]), e1 = __builtin_amdgcn_exp2f(p1[r]);
                        float s0 = __builtin_amdgcn_rcpf(1.f + e0), s1 = __builtin_amdgcn_rcpf(1.f + e1);
                        p0[r] = e0; p1[r] = e1;
                        if constexpr (MASK) { if (rel - kk <= 0) s0 = 1.f; if (rel - kk - 32 <= 0) s1 = 1.f; }
                        r0[r] = s0; r1[r] = s1; }
                    float Gs[16];
#pragma unroll
                    for (int g = 0; g < 4; ++g) { const float x0 = (r0[4 * g] * r0[4 * g + 1]) * (r0[4 * g + 2] * r0[4 * g + 3]), x1 = (r1[4 * g] * r1[4 * g + 1]) * (r1[4 * g + 2] * r1[4 * g + 3]);
                        auto ra = __builtin_amdgcn_permlane32_swap(__float_as_uint(x0), __float_as_uint(x0), false, false);
                        auto rb = __builtin_amdgcn_permlane32_swap(__float_as_uint(x1), __float_as_uint(x1), false, false);
                        Gs[2 * g] = __uint_as_float(ra[0]); Gs[2 * g + 1] = __uint_as_float(ra[1]); Gs[8 + 2 * g] = __uint_as_float(rb[0]); Gs[8 + 2 * g + 1] = __uint_as_float(rb[1]); }
                    float T[16]; T[15] = carry;
#pragma unroll
                    for (int jj = 14; jj >= 0; --jj) T[jj] = T[jj + 1] * Gs[jj + 1];
                    const float total = T[0] * Gs[0];
#pragma unroll
                    for (int g = 0; g < 4; ++g) {
                        float run0 = hi ? T[2 * g + 1] : T[2 * g], run1 = hi ? T[8 + 2 * g + 1] : T[8 + 2 * g];
#pragma unroll
                        for (int i = 3; i >= 0; --i) { const int r = 4 * g + i, kk = i + 8 * g;
                            run0 *= r0[r]; run1 *= r1[r];
                            float e0 = p0[r] * run0, e1 = p1[r] * run1;
                            if constexpr (MASK) { if (rel - kk <= 0) e0 = 0.f; if (rel - kk - 32 <= 0) e1 = 0.f; }
                            p0[r] = e0; p1[r] = e1; } }
                    carry = total;
                };
                if (needmask) sb_weights(std::true_type{}); else sb_weights(std::false_type{});
                done = __all(carry < SB_DONE);
            } else {
                float ra = max3f(p0[0], p0[1], p1[0]), rb = max3f(p0[2], p0[3], p1[1]); ra = max3f(ra, p1[2], p1[3]);
#pragma unroll
                for (int r = 4; r < 16; r += 4) { ra = max3f(ra, p0[r], p0[r + 1]); rb = max3f(rb, p0[r + 2], p0[r + 3]); ra = max3f(ra, p1[r], p1[r + 1]); rb = max3f(rb, p1[r + 2], p1[r + 3]); }
                const float rm = swap_max(__builtin_fmaxf(ra, rb));
                if (fresh || __any(rm > THR)) {
                    const float dl = fresh ? rm : fmaxf(rm, 0.f), al = fresh ? 1.f : __builtin_amdgcn_exp2f(-dl); mref += dl; osum[0] *= al;
#pragma unroll
                    for (int r = 0; r < 16; ++r) { p0[r] -= dl; p1[r] -= dl; cc0[r] = -mref; cc1[r] = -mref; }
                    if (!fresh) {
#pragma unroll
                        for (int d = 0; d < NB; ++d)
#pragma unroll
                            for (int r = 0; r < 16; ++r) o[d][r] *= al;
                    }
                    fresh = false;
                }
#pragma unroll
                for (int r = 0; r < 8; ++r) p0[r] = __builtin_amdgcn_exp2f(p0[r]);
            }
            pw[0] = (u32x4){cvtpk(p0[0], p0[1]), cvtpk(p0[2], p0[3]), cvtpk(p0[4], p0[5]), cvtpk(p0[6], p0[7])};
            if constexpr (SBM) {
            pw[1] = (u32x4){cvtpk(p0[8], p0[9]), cvtpk(p0[10], p0[11]), cvtpk(p0[12], p0[13]), cvtpk(p0[14], p0[15])};
            pw[2] = (u32x4){cvtpk(p1[0], p1[1]), cvtpk(p1[2], p1[3]), cvtpk(p1[4], p1[5]), cvtpk(p1[6], p1[7])};
            pw[3] = (u32x4){cvtpk(p1[8], p1[9]), cvtpk(p1[10], p1[11]), cvtpk(p1[12], p1[13]), cvtpk(p1[14], p1[15])};
            }
            const LAS unsigned char* vb = lds + bo + VOFF + vlane;
            s16x4 vbq[8];
            if constexpr (!SBM) {
#pragma unroll
                for (int d = 0; d < NB; ++d) { va[2 * d] = vtr(vb + d * 4096); va[2 * d + 1] = vtr(vb + d * 4096 + 512); }
                bf16x8 ones = (bf16x8){0x3F80, 0x3F80, 0x3F80, 0x3F80, 0x3F80, 0x3F80, 0x3F80, 0x3F80}; asm volatile("" : "+v"(ones));
#pragma unroll
                for (int ks = 0; ks < 4; ++ks) {
                    if (ks + 1 < 4) {
#pragma unroll
                        for (int d = 0; d < NB; ++d) { vbq[2 * d] = vtr(vb + d * 4096 + (ks + 1) * 1024); vbq[2 * d + 1] = vtr(vb + d * 4096 + (ks + 1) * 1024 + 512); }
                    }
                    __builtin_amdgcn_sched_barrier(0);
#pragma unroll
                    for (int d = 0; d < NB; ++d) { const s16x4 lo = va[2 * d], hh2 = va[2 * d + 1];
                        const bf16x8 vf = (bf16x8){lo[0], lo[1], lo[2], lo[3], hh2[0], hh2[1], hh2[2], hh2[3]};
                        o[d] = mfma32(vf, __builtin_bit_cast(bf16x8, pw[ks]), o[d]); }
                    osum = mfma32(ones, __builtin_bit_cast(bf16x8, pw[ks]), osum);
                    if (ks + 1 < 4) { float e[8];
#pragma unroll
                        for (int r = 0; r < 8; ++r) e[r] = __builtin_amdgcn_exp2f(ks == 0 ? p0[8 + r] : ks == 1 ? p1[r] : p1[8 + r]);
                        pw[ks + 1] = (u32x4){cvtpk(e[0], e[1]), cvtpk(e[2], e[3]), cvtpk(e[4], e[5]), cvtpk(e[6], e[7])}; }
                    __builtin_amdgcn_sched_barrier(0);
#pragma unroll
                    for (int i = 0; i < 8; ++i) va[i] = vbq[i];
                }
            } else
#pragma unroll
            for (int d = 0; d < NB; ++d) {
                if (d + 1 < NB) {
#pragma unroll
                    for (int ks = 0; ks < 4; ++ks) { vbq[2 * ks] = vtr(vb + (d + 1) * 4096 + ks * 1024); vbq[2 * ks + 1] = vtr(vb + (d + 1) * 4096 + ks * 1024 + 512); }
                }
                __builtin_amdgcn_sched_barrier(0);
#pragma unroll
                for (int ks = 0; ks < 4; ++ks) { const s16x4 lo = va[2 * ks], hh2 = va[2 * ks + 1];
                    const bf16x8 vf = (bf16x8){lo[0], lo[1], lo[2], lo[3], hh2[0], hh2[1], hh2[2], hh2[3]};
                    o[d] = mfma32(vf, __builtin_bit_cast(bf16x8, pw[ks]), o[d]); }
                __builtin_amdgcn_sched_barrier(0);
#pragma unroll
                for (int i = 0; i < 8; ++i) va[i] = vbq[i];
            }
          }
        }
        {
          const bool lastslot = (j == NT - 1); const int hg = j;
          ATT_FLAG_SET(hg); ATT_BAR(ahead);
          int brk; ATT_FLAG_ALL(hg, brk); if (brk) break;
        }
        b0 = (b0 == 2) ? 0 : b0 + 1;
    }
    __builtin_amdgcn_s_setprio(0);
#undef ATT_BAR
#undef ATT_FLAG_SET
#undef ATT_FLAG_ALL
#undef ATT_DMA_K
#undef ATT_DMA_V
    asm volatile("s_waitcnt vmcnt(0) lgkmcnt(0)\n\ts_barrier" ::: "memory");
    if (has_next) {
        const int qcn = (SBM ? 0 : 512) + np * 128 + c * 64, grn = (SBM ? 0 : 4) + np;
        const bf16_t* qg = P.q + ((size_t)nb * SEQ + nqb * 128 + 32 * wq + r32) * DM + qcn + hi * 8;
#pragma unroll
        for (int d0 = 0; d0 < 4; ++d0) qr[d0] = *(const GAS bf16x8*)(qg + d0 * 16);
        const size_t ro = ((size_t)((nb * 64) * 8 + grn) << 14) + wid * 1024 + lane * 16 + ((size_t)(2 * nqb + 1) << 17);
        glds16(P.kt + ro, (unsigned)__builtin_amdgcn_readfirstlane(lds0)); glds16(P.kt + ro + 8192, (unsigned)__builtin_amdgcn_readfirstlane(lds0 + KIMG));
        glds16(P.vt + ro, (unsigned)__builtin_amdgcn_readfirstlane(lds0 + VOFF)); glds16(P.vt + ro + 8192, (unsigned)__builtin_amdgcn_readfirstlane(lds0 + VOFF + 8192));
    }
    int lane_f = lane; asm volatile("" : "+v"(lane_f));
    const int n = lane_f & 31, hif = lane_f >> 5;
    const LAS float* gt = (const LAS float*)(lds + P.goff) + 4 * hif;
#define ATT_STORE_ROW(yrow_, scale_) do { _Pragma("unroll") for (int d = 0; d < NB; ++d) _Pragma("unroll") for (int gp = 0; gp < 2; ++gp) { \
        const f32x4 ga_ = *(const LAS f32x4*)(gt + 32 * d + 16 * gp), gb_ = *(const LAS f32x4*)(gt + 32 * d + 16 * gp + 8); \
        const unsigned x0_ = cvtpk(o[d][8 * gp] * (scale_) * ga_.x, o[d][8 * gp + 1] * (scale_) * ga_.y), x1_ = cvtpk(o[d][8 * gp + 2] * (scale_) * ga_.z, o[d][8 * gp + 3] * (scale_) * ga_.w); \
        const unsigned y0_ = cvtpk(o[d][8 * gp + 4] * (scale_) * gb_.x, o[d][8 * gp + 5] * (scale_) * gb_.y), y1_ = cvtpk(o[d][8 * gp + 6] * (scale_) * gb_.z, o[d][8 * gp + 7] * (scale_) * gb_.w); \
        auto s0_ = __builtin_amdgcn_permlane32_swap(x0_, y0_, false, false); auto s1_ = __builtin_amdgcn_permlane32_swap(x1_, y1_, false, false); \
        const unsigned a0_ = s0_[0], b0_ = s0_[1], a1_ = s1_[0], b1_ = s1_[1]; \
        *(u32x4*)((yrow_) + 32 * d + 16 * gp + 8 * hif) = (u32x4){a0_, a1_, b0_, b1_}; } } while (0)
    if constexpr (SBM) {
        const int hd = 2 * p + c;
        float s = 0.f;
#pragma unroll
        for (int d = 0; d < NB; ++d)
#pragma unroll
            for (int r = 0; r < 16; ++r) s += o[d][r] * o[d][r];
        const float ssr = __builtin_amdgcn_rsqf(xor32_sum(s) * (1.f / 64.f) + NORM_EPS);
        bf16_t* yrow = P.y + (rowbase + qw + n) * DM + hd * 64;
        ATT_STORE_ROW(yrow, ssr);
        asm volatile("s_waitcnt lgkmcnt(0)\n\ts_barrier" ::: "memory");
    } else {
        const float inv = 1.f / osum[0];
        LAS float* ex = (LAS float*)(lds + BUFB + wq * 16384) + lane;
        if (c == 1) {
#pragma unroll
            for (int d = 0; d < NB; ++d)
#pragma unroll
                for (int r = 0; r < 16; ++r) ex[(d * 16 + r) * 64] = o[d][r] * inv;
        }
        asm volatile("s_waitcnt lgkmcnt(0)\n\ts_barrier" ::: "memory");
        if (c == 0) {
            float s = 0.f;
#pragma unroll
            for (int d = 0; d < NB; ++d)
#pragma unroll
                for (int r = 0; r < 16; ++r) { const float v = o[d][r] * inv - P.lam * ex[(d * 16 + r) * 64]; o[d][r] = v; s += v * v; }
            const float ssr = P.outscale * __builtin_amdgcn_rsqf(xor32_sum(s) * (1.f / 128.f) + NORM_EPS);
            bf16_t* yrow = P.y + (rowbase + qw + n) * DM + 512 + p * 128;
            ATT_STORE_ROW(yrow, ssr);
        }
        asm volatile("s_waitcnt lgkmcnt(0)\n\ts_barrier" ::: "memory");
    }
#undef ATT_STORE_ROW
}
}

struct Args { const float* in[20]; float* out; unsigned char* ws; int ph_lo, ph_hi; };

__global__ void __launch_bounds__(NWAVES * 64, 2) mk_fwd(Args args) {
    extern __shared__ __attribute__((aligned(16))) unsigned char lds_raw[];
    LAS unsigned char* lds = (LAS unsigned char*)lds_raw;
    volatile LAS unsigned* MISC = (volatile LAS unsigned*)(lds + MISC_OFF);
    const int tid = threadIdx.x, wave = __builtin_amdgcn_readfirstlane(tid >> 6);
    const int Gk = gridDim.x; const int bx = blockIdx.x; const int vcu = (Gk % 8 == 0) ? (bx % 8) * (Gk / 8) + bx / 8 : bx;
    unsigned char* ws = args.ws;
    unsigned* ctl = (unsigned*)(ws + WS_CTL);
    for (int u = tid; u < (LDS_BYTES - LDSCTL_OFF) / 4; u += NWAVES * 64) ((LAS unsigned*)(lds + LDSCTL_OFF))[u] = 0u;
    __syncthreads();
    XcdBarrier bar = xcd_barrier_post(ctl + CW_BAR, MISC + 8);

    const int gw = vcu * NWAVES + wave;
    const int lo = args.ph_lo, hi = args.ph_hi;
    int ph = 0;
#define PH_ON (ph >= lo && ph < hi)
#define PH_END do { if (ph >= lo && ph + 1 < hi) xcd_barrier(bar); ++ph; } while (0)
#define PH_LOCALS int tl; asm volatile("v_mbcnt_lo_u32_b32 %0, -1, 0\n\tv_mbcnt_hi_u32_b32 %0, -1, %0" : "=v"(tl)); tl += wave * 64; asm volatile("" : "+v"(tl));        \
    const int lane = tl & 63; int G = Gk; asm volatile("" : "+s"(G)); const int NGW = G * NWAVES; (void)NGW; \
    const __attribute__((address_space(4))) Args* ap = (const __attribute__((address_space(4))) Args*)__builtin_amdgcn_kernarg_segment_ptr(); asm volatile("" : "+s"(ap)); \
    unsigned char* wl = ap->ws; \
    float* xs = ap->out; bf16_t* XB = (bf16_t*)(wl + WS_XB); (void)XB; bf16_t* ACT = (bf16_t*)(wl + WS_ACT); bf16_t* BIG = (bf16_t*)(wl + WS_BIG); int* cnt = (int*)(wl + WS_CTL) + CW_CNT; \
    int* row_t = (int*)(wl + WS_ROWT); float* row_g = (float*)(wl + WS_ROWG); (void)lane; (void)xs; (void)ACT; (void)BIG; (void)cnt; (void)row_t; (void)row_g

    if (PH_ON) {
        PH_LOCALS;
        bf16_t* Win_t = (bf16_t*)(wl + WS_WIN); bf16_t* Wout_t = (bf16_t*)(wl + WS_WOUT); bf16_t* Wgu_t = (bf16_t*)(wl + WS_WGU); bf16_t* Wd_t = (bf16_t*)(wl + WS_WD);

        LAS float* scr = (LAS float*)(lds + RING_OFF + wave * 16384);
        { f32x4 v[4], na[4], nb[4];
          load_row(ap->in[0] + (size_t)gw * DM, lane, na);
          load_row(ap->in[0] + (size_t)((gw + NGW < M) ? gw + NGW : gw) * DM, lane, nb);
          for (int m = gw; m < M; m += 2 * NGW) {
#pragma unroll
              for (int j = 0; j < 4; ++j) v[j] = na[j];
              if (m + 2 * NGW < M) load_row(ap->in[0] + (size_t)(m + 2 * NGW) * DM, lane, na);
              { float s2 = 0.f;
#pragma unroll
                for (int j = 0; j < 4; ++j) s2 += (v[j].x * v[j].x + v[j].y * v[j].y) + (v[j].z * v[j].z + v[j].w * v[j].w);
                s2 = wave_sum(s2);
                if (lane < 16) ((float*)(wl + WS_SSQ))[(size_t)m * 16 + lane] = lane == 0 ? s2 : 0.f;
                store_row_bf16(XB + (size_t)m * DM, lane, v); }
              if (m + NGW < M) {
#pragma unroll
                  for (int j = 0; j < 4; ++j) v[j] = nb[j];
                  if (m + 3 * NGW < M) load_row(ap->in[0] + (size_t)(m + 3 * NGW) * DM, lane, nb);
                  float s2 = 0.f;
#pragma unroll
                  for (int j = 0; j < 4; ++j) s2 += (v[j].x * v[j].x + v[j].y * v[j].y) + (v[j].z * v[j].z + v[j].w * v[j].w);
                  s2 = wave_sum(s2);
                  if (lane < 16) ((float*)(wl + WS_SSQ))[(size_t)(m + NGW) * 16 + lane] = lane == 0 ? s2 : 0.f;
                  store_row_bf16(XB + (size_t)(m + NGW) * DM, lane, v); } } }
#if MK_DUP & 4
        for (int rep = 0; rep < 2; ++rep)
#endif
        {
        for (int l = 0; l < 2; ++l) {
            transpose_matrix(ap->in[1] + (size_t)l * DM * QKV, DM, QKV, Win_t + (size_t)l * QKV * DM, false, 0, scr, gw, NGW, lane, ap->in[3] + l * DM, l * 2048);
            transpose_matrix(ap->in[2] + (size_t)l * DM * DM, DM, DM, Wout_t + (size_t)l * DM * DM, false, 0, scr, gw, NGW, lane, nullptr, l * 2048 + 1536);
        }
        if (DENSE_GU_FP8) {
            transpose_matrix8(ap->in[12], DM, FFD, (unsigned char*)Wgu_t, true, 0, scr, gw, NGW, lane, -32.f * LOG2E, 2048, ap->in[4]);
            transpose_matrix8(ap->in[13], DM, FFD, (unsigned char*)Wgu_t, true, 128, scr, gw, NGW, lane, -32.f / LOG2E, 2752, ap->in[4]);
        } else {
            transpose_matrix(ap->in[12], DM, FFD, Wgu_t, true, 0, scr, gw, NGW, lane, ap->in[4], 4096, -LOG2E);
            transpose_matrix(ap->in[13], DM, FFD, Wgu_t, true, 128, scr, gw, NGW, lane, ap->in[4], 5504, -1.f / LOG2E);
        }
        if (DENSE_DOWN_FP8) transpose_matrix8(ap->in[14], FFD, DM, (unsigned char*)Wd_t, false, 0, scr, gw, NGW, lane, 32.f, 1408);
        else transpose_matrix(ap->in[14], FFD, DM, Wd_t, false, 0, scr, gw, NGW, lane, nullptr, 6912);
        }
    }
    PH_END;

    for (int layer = 0; layer < 2; ++layer) {
        const float lambda_init = layer == 0 ? 0.2f : 0.35550906759f;
        if (PH_ON) {
            PH_LOCALS;
            pg8::Gemm g{XB, (bf16_t*)(wl + WS_WIN) + (size_t)layer * QKV * DM, DM}; pg8::StaticOrder S; S.init(M / 256, QKV / 256, G, bx);
            pg8::EpiProj E{BIG, (unsigned char*)BIG + (size_t)M * DM * 2, (unsigned char*)BIG + (size_t)M * DM * 4, (const float*)(wl + WS_SSQ)};
#if !(MK_SKIP & 16)
            pg8::gemm_phase<pg8::EpiProj, pg8::StaticOrder, true, false>(lds + RING_OFF, g, S, E, nullptr, tl);
#endif
#if MK_DUP & 8
            if (layer == 0) pg8::gemm_phase<pg8::EpiProj, pg8::StaticOrder, true, false>(lds + RING_OFF, g, S, E, nullptr, tl);
#endif
        }
        PH_END;
        if (PH_ON) {
            PH_LOCALS;
            LAS float* tbl = (LAS float*)(lds + TBL_OFF);
            for (int i = tl; i < 4 * 132; i += NWAVES * 64) { const int h = i / 132, d = i % 132; const int dd = d > 128 ? 128 : d;
                int bk = dd; if (dd >= 16) { bk = 16 + (int)(log2f((float)dd * (1.f / 16.f)) * (16.f / 3.f)); bk = bk > 31 ? 31 : bk; }
                tbl[i] = (ap->in[11][bk * 4 + h] - ap->in[11][31 * 4 + h]) * LOG2E; }
            if (tl < 192) ((LAS float*)(lds + GTAB_OFF))[tl] = tl < 128 ? ap->in[6][layer * 128 + tl] : ap->in[5][layer * 64 + tl - 128];
            if (wave == 0) { const float a = wave_sum(ap->in[7][layer * 64 + lane] * ap->in[8][layer * 64 + lane]), b2 = wave_sum(ap->in[9][layer * 64 + lane] * ap->in[10][layer * 64 + lane]);
                if (lane == 0) tbl[4 * 132] = expf(a) - expf(b2) + lambda_init; }
            __syncthreads();
            for (int i = tl; i < 4 * 4 * BT_N; i += NWAVES * 64) { const int h = i / (4 * BT_N), cpy = (i / BT_N) & 3, m = i % BT_N;
                int d = (BT_N - 1) - (m + cpy) - 100; d = d < 0 ? 0 : (d > 128 ? 128 : d);
                ((LAS float*)(lds + BT_OFF))[i] = tbl[h * 132 + d]; }
            __syncthreads();
            const unsigned char* KTb = (const unsigned char*)BIG + (size_t)M * DM * 2; const unsigned char* VTb = KTb + (size_t)M * DM * 2;
            att::Params PD{BIG, KTb, VTb, ACT, GTAB_OFF, tbl[4 * 132], 1.f - lambda_init};
            att::Params PS{BIG, KTb, VTb, ACT, GTAB_OFF + 512, 0.f, 1.f};
#if MK_DUP & 1
            for (int rep = 0; rep < (layer == 0 ? 2 : 1); ++rep)
#endif
            bf16x8 qfr[4];
#pragma unroll
            for (int d0 = 0; d0 < 4; ++d0) qfr[d0] = (bf16x8){0, 0, 0, 0, 0, 0, 0, 0};
            for (int ux = vcu; ux < 1024; ux += G) { const int i = ux >> 8, v = ux & 255, bp = v >> 3, s = v & 7;
                const int qb = (i == 0) ? s : (i == 1) ? 15 - s : (i == 2) ? 16 + s : 31 - s;
                const int un = ux + G, i2 = un >> 8, v2 = un & 255, bp2 = v2 >> 3, s2 = v2 & 7;
                const int qb2 = (i2 == 0) ? s2 : (i2 == 1) ? 15 - s2 : (i2 == 2) ? 16 + s2 : 31 - s2;
#if !(MK_SKIP & 1)
                att::unit<false>(lds, PD, bp >> 2, bp & 3, qb, tl, qfr, ux == vcu, un < 1024, bp2 >> 2, bp2 & 3, qb2);
#endif
            }
#if MK_DUP & 2
            for (int rep = 0; rep < (layer == 0 ? 2 : 1); ++rep)
#endif
            for (int ux = vcu; ux < 1024; ux += G) { const int i = ux >> 8, v = ux & 255, bp = v >> 3, s = v & 7;
                const int qb = (i == 0) ? s : (i == 1) ? 15 - s : (i == 2) ? 16 + s : 31 - s;
                const int un = ux + G, i2 = un >> 8, v2 = un & 255, bp2 = v2 >> 3, s2 = v2 & 7;
                const int qb2 = (i2 == 0) ? s2 : (i2 == 1) ? 15 - s2 : (i2 == 2) ? 16 + s2 : 31 - s2;
#if !(MK_SKIP & 2)
                att::unit<true>(lds, PS, bp >> 2, bp & 3, qb, tl, qfr, ux == vcu, un < 1024, bp2 >> 2, bp2 & 3, qb2);
#endif
            }
        }
        PH_END;
        if (PH_ON) {
            PH_LOCALS;
            pg8::Gemm g{ACT, (bf16_t*)(wl + WS_WOUT) + (size_t)layer * DM * DM, DM}; pg8::StaticOrder S; S.init(M / 256, DM / 256, G, bx);
            if (DENSE_GU_FP8 && layer == 0) {
                pg8::EpiRes<true> E{XB, (float*)(wl + WS_SSQ), wl + WS_ACT8};
                pg8::gemm_phase<pg8::EpiRes<true>, pg8::StaticOrder, true, false>(lds + RING_OFF, g, S, E, nullptr, tl);
            } else {
                pg8::EpiRes<false> E{XB, (float*)(wl + WS_SSQ)};
                pg8::gemm_phase<pg8::EpiRes<false>, pg8::StaticOrder, true, false>(lds + RING_OFF, g, S, E, nullptr, tl);
            }

        }
        PH_END;
        if (layer == 1) {
        if (PH_ON) {
            PH_LOCALS;
            const float* gain = ap->in[4] + layer * DM;
            {
                int* tok_e = (int*)(wl + WS_TOKE); int* tok_p = (int*)(wl + WS_TOKP); float* tok_g = (float*)(wl + WS_TOKG);
                LAS float* rw = (LAS float*)(lds + RING_OFF);
                LAS int* se = (LAS int*)(lds + RING_OFF + 32768);
                LAS float* sg = (LAS float*)(lds + RING_OFF + 32768 + 1024);
                LAS int* srank = (LAS int*)(lds + RING_OFF + 32768 + 2048);
                LAS int* sbase = (LAS int*)(lds + RING_OFF + 32768 + 3072);
                LAS float* gl = (LAS float*)(lds + RING_OFF + 40960);
                gl[tl] = gain[tl]; gl[tl + NWAVES * 64] = gain[tl + NWAVES * 64];
                { f32x4 rv[4];
#pragma unroll
                  for (int j = 0; j < 4; ++j) rv[j] = *(const GAS f32x4*)(ap->in[15] + 4 * (tl + j * NWAVES * 64));
#pragma unroll
                  for (int j = 0; j < 4; ++j) { const int i4 = tl + j * NWAVES * 64, col = i4 >> 1, e0 = (i4 & 1) * 4;
                      rw[(e0 + 0) * DM + col] = rv[j].x; rw[(e0 + 1) * DM + col] = rv[j].y; rw[(e0 + 2) * DM + col] = rv[j].z; rw[(e0 + 3) * DM + col] = rv[j].w; } }
#pragma unroll 1
                for (int i = bx * NWAVES * 64 + tl; i < 2 * MOE_ROWS; i += G * NWAVES * 64) row_t[i] = -1;
                __syncthreads();
                for (int blk = vcu; blk < M / 128; blk += G) {
                    u32x2 na[4], nb[4]; const bf16_t* xb0 = XB + (size_t)(blk * 128 + wave * 16) * DM;
                    load_row_bf(xb0, lane, na); load_row_bf(xb0 + DM, lane, nb);
#pragma unroll 1
                    for (int rr = 0; rr < 16; rr += 2) { const int lr = wave * 16 + rr, m = blk * 128 + lr;
                        f32x4 v0[4], v1[4]; cvt_row(na, v0); cvt_row(nb, v1);
                        { const int r2 = (rr + 2 < 16) ? rr + 2 : rr;
                          load_row_bf(xb0 + (size_t)r2 * DM, lane, na); load_row_bf(xb0 + (size_t)(r2 + 1) * DM, lane, nb); }
                        norm_row_l(gl, lane, v0); norm_row_l(gl, lane, v1);
                        { GAS unsigned* o8 = (GAS unsigned*)(wl + WS_ACT8 + (size_t)m * DM) + lane;
#pragma unroll
                          for (int j = 0; j < 4; ++j) { o8[64 * j] = pk4_fp8(v0[j].x, v0[j].y, v0[j].z, v0[j].w); o8[DM / 4 + 64 * j] = pk4_fp8(v1[j].x, v1[j].y, v1[j].z, v1[j].w); } }
                        float la[NE], lb[NE];
#pragma unroll
                        for (int e = 0; e < NE; ++e) { la[e] = 0.f; lb[e] = 0.f; }
#pragma unroll
                        for (int j = 0; j < 4; ++j) { f32x4 w[NE];
#pragma unroll
                            for (int e = 0; e < NE; ++e) w[e] = *(const LAS f32x4*)(rw + e * DM + 4 * lane + 256 * j);
                            asm volatile("" ::: "memory");
#pragma unroll
                            for (int e = 0; e < NE; ++e) {
                                la[e] += (v0[j].x * w[e].x + v0[j].y * w[e].y) + (v0[j].z * w[e].z + v0[j].w * w[e].w); lb[e] += (v1[j].x * w[e].x + v1[j].y * w[e].y) + (v1[j].z * w[e].z + v1[j].w * w[e].w); } }
#pragma unroll
                        for (int e = 0; e < NE; ++e) { la[e] = wave_sum(la[e]); lb[e] = wave_sum(lb[e]); }
#pragma unroll
                        for (int h = 0; h < 2; ++h) {
                            int i1 = 0; float l1 = h ? lb[0] : la[0];
#pragma unroll
                            for (int e = 1; e < NE; ++e) { const float le = h ? lb[e] : la[e]; if (le > l1) { l1 = le; i1 = e; } }
                            int i2 = -1; float l2 = -INFINITY;
#pragma unroll
                            for (int e = 0; e < NE; ++e) { const float le = h ? lb[e] : la[e]; if (e != i1 && le > l2) { l2 = le; i2 = e; } }
                            const float ex = expf(l2 - l1), g1 = 1.f / (1.f + ex), g2 = ex * g1;
                            if (lane == 0) { se[lr + h] = i1; se[128 + lr + h] = i2; sg[lr + h] = g1; sg[128 + lr + h] = g2; }
                        }
                    }
                    __syncthreads();
                    if (tl < 16) { const int k = tl >> 3, e = tl & 7; int c = 0;
                        typedef int se4_t __attribute__((ext_vector_type(4))); const LAS se4_t* sp = (const LAS se4_t*)(se + k * 128);
                        for (int r4 = 0; r4 < 32; ++r4) { const se4_t q = sp[r4]; LAS int* sr = srank + k * 128 + 4 * r4;
                            if (q.x == e) { sr[0] = c; ++c; } if (q.y == e) { sr[1] = c; ++c; } if (q.z == e) { sr[2] = c; ++c; } if (q.w == e) { sr[3] = c; ++c; } }
                        sbase[tl] = c ? (int)__hip_atomic_fetch_add((unsigned*)&cnt[tl], (unsigned)c, RLX_AGENT) : 0; }
                    __syncthreads();
                    if (tl < 256) { const int k = tl >> 7, r = tl & 127, m = blk * 128 + r, e = se[k * 128 + r];
                        tok_e[k * M + m] = e; tok_p[k * M + m] = sbase[k * 8 + e] + srank[k * 128 + r]; tok_g[k * M + m] = sg[k * 128 + r]; }
                    __syncthreads();
                }
            }
        }
        PH_END;
        }
        if (layer == 0) {
            if (PH_ON) {
                PH_LOCALS;
                pg8::Gemm g{DENSE_GU_FP8 ? (const bf16_t*)(wl + WS_ACT8) : XB, (bf16_t*)(wl + WS_WGU), DM, DENSE_GU_FP8 ? 0x7C7C7C7C : 0x7F7F7F7F, (DENSE_GU_FP8 && DENSE_DOWN_FP8) ? 0x7D7D7D7D : 0x7A7A7A7A};
                pg8::StaticOrder S; S.init(M / 256, NGU_D / 256, G, bx);
                pg8::EpiSwiGLU<true, DENSE_DOWN_FP8 != 0> E{BIG, FFD, NGU_D / 256, (const float*)(wl + WS_SSQ)};
#if !(MK_SKIP & 64)
                pg8::gemm_phase<pg8::EpiSwiGLU<true, DENSE_DOWN_FP8 != 0>, pg8::StaticOrder, true, false, DENSE_GU_FP8 != 0>(lds + RING_OFF, g, S, E, nullptr, tl);
#endif
#if MK_DUP & 16
                pg8::gemm_phase<pg8::EpiSwiGLU<true, DENSE_DOWN_FP8 != 0>, pg8::StaticOrder, true, false>(lds + RING_OFF, g, S, E, nullptr, tl);
#endif
            }
            PH_END;
            if (PH_ON) {
                PH_LOCALS;
                pg8::Gemm g{BIG, (bf16_t*)(wl + WS_WD), FFD, DENSE_DOWN_FP8 ? 0x7C7C7C7C : 0x7F7F7F7F}; pg8::StaticOrder S; S.init(M / 256, DM / 256, G, bx);
                pg8::EpiRes<false> E{XB, (float*)(wl + WS_SSQ)};
#if !(MK_SKIP & 128)
                pg8::gemm_phase<pg8::EpiRes<false>, pg8::StaticOrder, true, false, DENSE_DOWN_FP8 != 0>(lds + RING_OFF, g, S, E, nullptr, tl);
#endif
            }
            PH_END;
        } else {
            if (PH_ON) {
                PH_LOCALS;
                { LAS float* scr = (LAS float*)(lds + RING_OFF + wave * 16384);
                  for (int e = 0; e < NE; ++e) {
                      transpose_matrix8(ap->in[16] + (size_t)e * DM * FFE, DM, FFE, (unsigned char*)(wl + WS_EGU8) + (size_t)e * NGU_E * DM, true, 0, scr, gw, NGW, lane, -32.f * LOG2E, (3 * e) * 896);
                      transpose_matrix8(ap->in[17] + (size_t)e * DM * FFE, DM, FFE, (unsigned char*)(wl + WS_EGU8) + (size_t)e * NGU_E * DM, true, 128, scr, gw, NGW, lane, -32.f / LOG2E, (3 * e + 1) * 896);
                      transpose_matrix8(ap->in[18] + (size_t)e * FFE * DM, FFE, DM, (unsigned char*)(wl + WS_ED) + (size_t)e * DM * FFE, false, 0, scr, gw, NGW, lane, 32.f, (3 * e + 2) * 896);
                  } }
                const int* tok_e = (const int*)(wl + WS_TOKE); const int* tok_p = (const int*)(wl + WS_TOKP); const float* tok_g = (const float*)(wl + WS_TOKG);
                int tiles[16];
#pragma unroll
                for (int j = 0; j < 16; ++j) tiles[j] = cnt[j];
                asm volatile("" ::: "memory");
#pragma unroll
                for (int j = 0; j < 16; ++j) tiles[j] = (tiles[j] + 255) >> 8;
#pragma unroll 1
                for (int i = bx * NWAVES * 64 + tl; i < 2 * M; i += G * NWAVES * 64) { const int k = i / M, m = i % M, e = tok_e[i];
                    int st = 0;
#pragma unroll
                    for (int j = 0; j < 8; ++j) st += (j < e) ? (k ? tiles[8 + j] : tiles[j]) : 0;
                    const int dest = st * 256 + tok_p[i];
                    row_t[k * MOE_ROWS + dest] = m; row_g[k * MOE_ROWS + dest] = tok_g[i]; }
            }
            PH_END;
            { PH_LOCALS; if (tl == 0) { typedef int ct4_t __attribute__((ext_vector_type(4)));
                  const GAS ct4_t* cp = (const GAS ct4_t*)cnt; const ct4_t c0 = cp[0], c1 = cp[1], c2 = cp[2], c3 = cp[3];
                  asm volatile("" ::: "memory");
                  const int cv[16] = {c0.x, c0.y, c0.z, c0.w, c1.x, c1.y, c1.z, c1.w, c2.x, c2.y, c2.z, c2.w, c3.x, c3.y, c3.z, c3.w};
#pragma unroll
                  for (int k = 0; k < 2; ++k) { int st = 0;
#pragma unroll
                      for (int e = 0; e < NE; ++e) { st += (cv[k * 8 + e] + 255) >> 8; MISC[16 + 8 * k + e] = (unsigned)st; } } } }
            __syncthreads();
            const int T0 = (int)MISC[16 + NE - 1], T1 = (int)MISC[24 + NE - 1];
            const int h0 = (T0 + 1) >> 1, h1 = (T1 - 64 > ((T1 + 1) >> 1)) ? T1 - 64 : ((T1 + 1) >> 1);
#pragma unroll 1
            for (int ci = -1; ci < 3; ++ci) {
                if (PH_ON) {
                    PH_LOCALS;
                    const int cd = ci, cg = ci + 1;
                    const int d_t0 = (cd == 2) ? h1 : 0, d_t1 = (cd == 0) ? T0 : (cd == 1) ? h1 : T1;
                    const int g_t0 = (cg == 2) ? h1 : 0, g_t1 = (cg == 0) ? T0 : (cg == 1) ? h1 : T1; (void)h0;
                    const int Ld = (cd >= 0) ? (d_t1 - d_t0) * (DM / 256) : 0;
                    if (cd >= 0) {
                        const int k = cd > 0 ? 1 : 0; bf16_t* HB = (bf16_t*)(wl + ((cd == 1) ? WS_HB1 : WS_BIG));
                        pg8::Gemm g{(const bf16_t*)((const unsigned char*)HB - (size_t)d_t0 * 256 * FFE), (const bf16_t*)(wl + WS_ED), FFE, 0x7C7C7C7C};
                        pg8::ChunkOrder S; S.S.init(d_t1 - d_t0, DM / 256, G, bx); S.t0 = d_t0; S.tend = (const volatile LAS int*)(MISC + 16 + 8 * k); S.xe = 0; S.li = 0; S.nl = 0; S.E = 0;
                        pg8::EpiMoeDown E{XB, row_t + k * MOE_ROWS, row_g + k * MOE_ROWS, 1.f};
#if !(MK_SKIP & 8)
                        pg8::gemm_phase<pg8::EpiMoeDown, pg8::ChunkOrder, true, false, true>(lds + RING_OFF, g, S, E, nullptr, tl);
#endif
                    }
                    if (cg < 3) {
                        const int k = cg > 0 ? 1 : 0; bf16_t* HB = (bf16_t*)(wl + ((cg == 1) ? WS_HB1 : WS_BIG));
                        pg8::Gemm g{(const bf16_t*)(wl + WS_ACT8), (const bf16_t*)(wl + WS_EGU8), DM, 0x7F7F7F7F, 0x7D7D7D7D};
                        pg8::ChunkOrder S; S.S.init(g_t1 - g_t0, NGU_E / 256, G, bx); S.t0 = g_t0; S.tend = (const volatile LAS int*)(MISC + 16 + 8 * k);
                        const int rem = Ld % G; S.xe = 0; S.li = 0; S.nl = 0; S.E = 0;
                        if (rem > 0) { S.nl = G - rem; const int Ecap = 4 * S.nl; S.E = S.S.nwg < Ecap ? S.S.nwg : Ecap;
                            if (bx >= rem) { S.li = bx - rem; for (int q = 0; q < 4; ++q) S.xe += (S.li + q * S.nl < S.E) ? 1 : 0; } }
                        pg8::EpiSwiGLU<false, true> E{(bf16_t*)((unsigned char*)HB - (size_t)g_t0 * 256 * FFE), FFE, NGU_E / 256, nullptr};
#if !(MK_SKIP & 4)
                        pg8::gemm_phase<pg8::EpiSwiGLU<false, true>, pg8::ChunkOrder, true, true, true>(lds + RING_OFF, g, S, E, row_t + k * MOE_ROWS, tl);
#endif
                    }
                }
                PH_END;
            }
#if MK_DUP & 1024
            for (int rep = 0; rep < 16; ++rep) xcd_barrier(bar);
#endif
            if (PH_ON) {
                PH_LOCALS;
                LAS float* gl = (LAS float*)(lds + RING_OFF);
                gl[tl] = ap->in[19][tl]; gl[tl + NWAVES * 64] = ap->in[19][tl + NWAVES * 64];
                __syncthreads();
                f32x4 v[4]; u32x2 na[4], nb[4];
                load_row_bf<true>(XB + (size_t)gw * DM, lane, na);
                load_row_bf<true>(XB + (size_t)((gw + NGW < M) ? gw + NGW : gw) * DM, lane, nb);
                for (int m = gw; m < M; m += 2 * NGW) {
                    cvt_row(na, v);
                    if (m + 2 * NGW < M) load_row_bf<true>(XB + (size_t)(m + 2 * NGW) * DM, lane, na);
                    norm_row_l(gl, lane, v);
                    { GAS f32x4* o = (GAS f32x4*)(xs + (size_t)m * DM) + lane;
#pragma unroll
                      for (int j = 0; j < 4; ++j) __builtin_nontemporal_store(v[j], o + 64 * j); }
                    if (m + NGW < M) {
                        cvt_row(nb, v);
                        if (m + 3 * NGW < M) load_row_bf<true>(XB + (size_t)(m + 3 * NGW) * DM, lane, nb);
                        norm_row_l(gl, lane, v);
                        GAS f32x4* o = (GAS f32x4*)(xs + (size_t)(m + NGW) * DM) + lane;
#pragma unroll
                        for (int j = 0; j < 4; ++j) __builtin_nontemporal_store(v[j], o + 64 * j); } }
            }
            ++ph;
        }
    }
#undef PH_ON
#undef PH_END
#undef PH_LOCALS
}

#ifndef MK_SKIP
#define MK_SKIP 0
#endif
#ifndef MK_N_LAUNCHES
#define MK_N_LAUNCHES 1
#endif
constexpr int N_PHASES = 16;
extern "C" void kernel_launch(void* const* d_in, const int* in_sizes, int n_in, void* d_out, int out_size, void* d_ws, size_t ws_size, hipStream_t stream) {
    static int grid = 0;
    if (grid == 0) {
        if (n_in != 20 || in_sizes[0] != M * DM || out_size != M * DM || ws_size < WS_END) { fprintf(stderr, "kernel_launch: unexpected shapes / workspace (n_in %d, ws %zu < %zu)\n", n_in, ws_size, (size_t)WS_END); grid = -1; return; }
        int dev = 0, cus = 0, per_cu = 0;
        if (hipGetDevice(&dev) != hipSuccess || hipDeviceGetAttribute(&cus, hipDeviceAttributeMultiprocessorCount, dev) != hipSuccess) { grid = -1; return; }
        if (hipFuncSetAttribute((const void*)mk_fwd, hipFuncAttributeMaxDynamicSharedMemorySize, LDS_BYTES) != hipSuccess) { fprintf(stderr, "kernel_launch: hipFuncSetAttribute failed\n"); grid = -1; return; }
        if (hipOccupancyMaxActiveBlocksPerMultiprocessor(&per_cu, (const void*)mk_fwd, NWAVES * 64, LDS_BYTES) != hipSuccess || per_cu < 1) { fprintf(stderr, "kernel_launch: occupancy query says %d\n", per_cu); }
        (void)hipGetLastError();
        grid = cus;
    }
    if (grid < 0) return;
    if (hipMemsetAsync((char*)d_ws + WS_CTL, 0, CTL_ZERO_BYTES, stream) != hipSuccess) return;
    Args a{};
    for (int i = 0; i < 20; ++i) a.in[i] = (const float*)d_in[i];
    a.out = (float*)d_out; a.ws = (unsigned char*)d_ws;
#if MK_N_LAUNCHES == 1
    a.ph_lo = 0; a.ph_hi = N_PHASES;
    hipLaunchKernelGGL(mk_fwd, dim3(grid), dim3(NWAVES * 64), LDS_BYTES, stream, a);
#else
    for (int p = 0; p < N_PHASES; ++p) { a.ph_lo = p; a.ph_hi = p + 1; hipLaunchKernelGGL(mk_fwd, dim3(grid), dim3(NWAVES * 64), LDS_BYTES, stream, a); }
#endif
}
```

```cpp
#include <hip/hip_runtime.h>
#include <cstdio>
#include <cstdint>
#include <type_traits>

#ifndef MK_SKIP
#define MK_SKIP 0
#endif
#ifndef MK_DUP
#define MK_DUP 0
#endif
#ifndef DENSE_FP8
#define DENSE_FP8 0
#endif
static_assert(DENSE_FP8 == 0, "superseded by DENSE_GU_FP8");
#ifndef DENSE_GU_FP8
#define DENSE_GU_FP8 1
#endif
#ifndef DENSE_DOWN_FP8
#define DENSE_DOWN_FP8 0
#endif
#define GAS __attribute__((address_space(1)))
#define LAS __attribute__((address_space(3)))

typedef unsigned short bf16_t;
typedef short bf16x8 __attribute__((ext_vector_type(8)));
typedef short s16x4 __attribute__((ext_vector_type(4)));
typedef float f32x4 __attribute__((ext_vector_type(4)));
typedef float f32x16 __attribute__((ext_vector_type(16)));
typedef unsigned u32x4 __attribute__((ext_vector_type(4)));
typedef unsigned u32x2 __attribute__((ext_vector_type(2)));

constexpr int BATCH = 8, SEQ = 4096, DM = 1024, M = BATCH * SEQ;
constexpr int QKV = 3072;
constexpr int FFD = 2816, NGU_D = 2 * FFD;
constexpr int NE = 8, FFE = 3584, NGU_E = 2 * FFE;
constexpr int MOE_TILES = M / 256 + NE, MOE_ROWS = MOE_TILES * 256;
constexpr float NORM_EPS = 1e-6f;
constexpr float LOG2E = 1.4426950408889634f;
constexpr float C2 = 0.125f * LOG2E;

constexpr size_t MiB = 1u << 20;
constexpr size_t WS_CTL = 0, CTL_ZERO_BYTES = 32 * 1024;
constexpr size_t WS_TOKE = 1 * MiB;
constexpr size_t WS_TOKP = WS_TOKE + 2 * (size_t)M * 4;
constexpr size_t WS_TOKG = WS_TOKP + 2 * (size_t)M * 4;
constexpr size_t WS_ROWT = WS_TOKG + 2 * (size_t)M * 4;
constexpr size_t WS_ROWG = WS_ROWT + 2 * (size_t)MOE_ROWS * 4;
static_assert(WS_ROWG + 2 * (size_t)MOE_ROWS * 4 <= 8 * MiB, "small tables");
constexpr size_t WS_SSQ = 4 * MiB;
constexpr size_t WS_WIN = 8 * MiB;
constexpr size_t WS_WOUT = 20 * MiB;
constexpr size_t WS_WGU = 24 * MiB;
constexpr size_t WS_WD = 35 * MiB;
constexpr size_t WS_EGU = 41 * MiB;
constexpr size_t WS_EGU8 = WS_EGU;
constexpr size_t WS_ACT8 = WS_EGU + 64 * MiB;
constexpr size_t WS_ED = 153 * MiB;
constexpr size_t WS_ACT = 209 * MiB;
constexpr size_t WS_BIG = 273 * MiB;
constexpr size_t WS_HB1 = WS_BIG + 128 * MiB;
constexpr size_t WS_XB = WS_BIG + 192 * MiB;
constexpr size_t WS_END = 529 * MiB;
static_assert(WS_XB + (size_t)M * DM * 2 <= WS_END && WS_BIG + (size_t)M * QKV * 2 <= WS_XB, "XB");
static_assert(WS_HB1 + (size_t)73 * 256 * FFE <= WS_XB && WS_BIG + (size_t)MOE_TILES * 256 * FFE <= WS_HB1, "d_ws map");
constexpr int CW_TMO = 0, CW_CODE = 1;
constexpr int CW_CNT = 64;
constexpr int CW_BAR = 4096;

constexpr int RING_OFF = 0, RING_BYTES = 131072;
constexpr int LDSCTL_OFF = RING_BYTES, MISC_OFF = LDSCTL_OFF + 320;
constexpr int TBL_OFF = LDSCTL_OFF + 1024;
constexpr int GTAB_OFF = TBL_OFF + 2304;
constexpr int ZERO_OFF = GTAB_OFF + 768;
constexpr int BT_OFF = ZERO_OFF + 512, BT_N = 328;
constexpr int LDS_BYTES = BT_OFF + 4 * 4 * BT_N * 4;
static_assert(LDS_BYTES <= 163840 && BT_OFF % 16 == 0, "LDS map");
constexpr int NWAVES = 8;

#define RLX_AGENT __ATOMIC_RELAXED, __HIP_MEMORY_SCOPE_AGENT
#define LDS_WAIT() asm volatile("s_waitcnt lgkmcnt(0)" ::: "memory")
#define VM_WAIT() asm volatile("s_waitcnt vmcnt(0)" ::: "memory")

__device__ __forceinline__ unsigned f2bf(float f) { unsigned u = __builtin_bit_cast(unsigned, f); return (u + 0x7fffu + ((u >> 16) & 1u)) >> 16; }
__device__ __forceinline__ unsigned pk2(float lo, float hi) { return f2bf(lo) | (f2bf(hi) << 16); }
typedef float f32x2_t __attribute__((ext_vector_type(2))); typedef __bf16 bf16x2_t __attribute__((ext_vector_type(2)));
__device__ __forceinline__ unsigned cvt_pk_bf16(float lo, float hi) { f32x2_t v = {lo, hi}; bf16x2_t b = __builtin_convertvector(v, bf16x2_t); return __builtin_bit_cast(unsigned, b); }
__device__ __forceinline__ unsigned pk4_fp8(float a, float b, float c, float d) {
    a = __builtin_amdgcn_fmed3f(a, -448.f, 448.f); b = __builtin_amdgcn_fmed3f(b, -448.f, 448.f); c = __builtin_amdgcn_fmed3f(c, -448.f, 448.f); d = __builtin_amdgcn_fmed3f(d, -448.f, 448.f);
    int w = 0; w = __builtin_amdgcn_cvt_pk_fp8_f32(a, b, w, false); w = __builtin_amdgcn_cvt_pk_fp8_f32(c, d, w, true); return (unsigned)w; }
__device__ __forceinline__ float bf_lo(unsigned w) { return __builtin_bit_cast(float, w << 16); }
__device__ __forceinline__ float bf_hi(unsigned w) { return __builtin_bit_cast(float, w & 0xffff0000u); }
template <int CTRL> __device__ __forceinline__ float dpp_f(float v) { return __builtin_bit_cast(float, __builtin_amdgcn_update_dpp(0, __builtin_bit_cast(int, v), CTRL, 0xF, 0xF, true)); }
__device__ __forceinline__ float sum16(float v) {
    v += dpp_f<0xB1>(v); v += dpp_f<0x4E>(v); v += dpp_f<0x141>(v); v += dpp_f<0x140>(v); return v; }
__device__ __forceinline__ float xor16_sum(float v) { auto rr = __builtin_amdgcn_permlane16_swap(__builtin_bit_cast(unsigned, v), __builtin_bit_cast(unsigned, v), false, false); const unsigned r0 = rr[0], r1 = rr[1]; return __uint_as_float(r0) + __uint_as_float(r1); }
__device__ __forceinline__ float xor32_sum(float v) { auto rr = __builtin_amdgcn_permlane32_swap(__builtin_bit_cast(unsigned, v), __builtin_bit_cast(unsigned, v), false, false); const unsigned r0 = rr[0], r1 = rr[1]; return __uint_as_float(r0) + __uint_as_float(r1); }
__device__ __forceinline__ float sum32(float v) { return xor16_sum(sum16(v)); }
__device__ __forceinline__ float wave_sum(float v) { return xor32_sum(xor16_sum(sum16(v))); }

namespace pg8 {
constexpr int BM = 256, BK = 64, HALF = 128, HTB = HALF * BK * 2, NXCD = 8, WGM = 8;
__host__ __device__ __forceinline__ int lds_byte(int r, int c) { const int st = (r >> 4) * 2 + (c >> 5), rr = r & 15, cc = c & 31, ob = rr * 64 + cc * 2; return st * 1024 + (ob ^ (((ob >> 9) & 1) << 5)); }
__host__ __device__ __forceinline__ void stage_rc(int b, int& R, int& C) { const int st = b / 1024, sb = b % 1024, swz = sb ^ (((sb >> 9) & 1) << 5); R = (st >> 1) * 16 + swz / 64; C = (st & 1) * 32 + (swz % 64) / 2; }
__host__ __device__ __forceinline__ int perm32(int rho) { const int n = rho >> 4, i = rho & 15; return 8 * (i >> 2) + 4 * n + (i & 3); }

struct Unit { int pm, pn; };
struct Gemm { const bf16_t* A; const bf16_t* Bt; int K; int sx = 0x7F7F7F7F; int su = 0x7A7A7A7A; };

struct StaticOrder {
    int nM, nN, nwg, G, c;
    __device__ void init(int nM_, int nN_, int G_, int c_) { nM = nM_; nN = nN_; nwg = nM * nN; G = G_; c = c_; }
    __device__ bool next(int i, Unit& u) const { const long L = (long)i * G + c; if (L >= nwg) return false; unit_at(L, u); return true; }
    __device__ void unit_at(long L, Unit& u) const {
        int wgid = (int)L; { const int q = nwg / NXCD, r = nwg % NXCD, xcd = wgid % NXCD, off = wgid / NXCD; wgid = (xcd < r ? xcd * (q + 1) : r * (q + 1) + (xcd - r) * q) + off; }
        const int nig = WGM * nN, gid = wgid / nig, fm = gid * WGM, gsz = (nM - fm) < WGM ? (nM - fm) : WGM;
        u.pm = fm + ((wgid % nig) % gsz); u.pn = (wgid % nig) / gsz;
    }
};
struct ChunkOrder {
    StaticOrder S; int t0; const volatile LAS int* tend; int xe, li, nl, E;
    __device__ bool next(int i, Unit& u) const {
        const long L = (i < xe) ? (long)li + (long)i * nl : (long)E + S.c + (long)(i - xe) * S.G;
        if (L >= S.nwg) return false;
        S.unit_at(L, u); u.pm += t0;
        typedef int te4_t __attribute__((ext_vector_type(4)));
        const LAS te4_t* tp = (const LAS te4_t*)tend; const te4_t ta = tp[0], tb = tp[1];
        const int e = ((u.pm >= ta.x) ? 1 : 0) + ((u.pm >= ta.y) ? 1 : 0) + ((u.pm >= ta.z) ? 1 : 0) + ((u.pm >= ta.w) ? 1 : 0) + ((u.pm >= tb.x) ? 1 : 0) + ((u.pm >= tb.y) ? 1 : 0) + ((u.pm >= tb.z) ? 1 : 0);
        u.pn += e * S.nN; return true;
    }
};

typedef int v8i __attribute__((ext_vector_type(8))); typedef int v4i __attribute__((ext_vector_type(4)));
__device__ __forceinline__ v8i ld32(const LAS unsigned char* p) { const v4i a = *(const LAS v4i*)p, b = *(const LAS v4i*)(p + 16); return __builtin_shufflevector(a, b, 0, 1, 2, 3, 4, 5, 6, 7); }
template <class Epi, class Sched, bool ALIGN_EPI, bool GATHER, bool FP8 = false>
__device__ __forceinline__ void gemm_phase(LAS unsigned char* lds, const Gemm g, const Sched& S, const Epi& E, const int* rowidx, const int tid) {
    const int wid = __builtin_amdgcn_readfirstlane(tid >> 6), lane = tid & 63, wr = wid >> 2, wc = wid & 3, fr = lane & 15, fq = lane >> 4;
    const int rb = FP8 ? g.K : 2 * g.K; int nt = rb / 128;
    if constexpr (FP8) asm volatile("" : "+s"(nt));
    unsigned voffA[2], voffB[2];
#pragma unroll
    for (int i = 0; i < 2; ++i) { int R, C; stage_rc(tid * 16 + i * 8192, R, C); const int Rb = (R & ~31) + perm32(R & 31);
        voffA[i] = (unsigned)(R * rb + 2 * C); voffB[i] = (unsigned)(Rb * rb + 2 * C); }
    const size_t kstep = (size_t)(BK * 2);
    const size_t hstep = (size_t)HALF * rb;
    const size_t tstep = 2 * hstep;
    const unsigned ldsw = (unsigned)wid * 1024u;
    const int aoff = lds_byte(wr * 64 + fr, FP8 ? fq * 16 : fq * 8), boff = lds_byte(wc * 32 + fr, FP8 ? fq * 16 : fq * 8);
#define PG8_SA(b, h) (((b) * 2 + (h)) * HTB)
#define PG8_SB(b, h) ((4 + (b) * 2 + (h)) * HTB)
#define PG8_STAGE(bufoff, gbase, voff) do { _Pragma("unroll") for (int _i = 0; _i < 2; ++_i) \
        __builtin_amdgcn_global_load_lds((const unsigned*)((const char*)(gbase) + (voff)[_i]), (LAS unsigned*)(lds + (bufoff) + ldsw + _i * 8192), 16, 0, 0); } while (0)
#define PG8_LDA(dst, b, h) do { if constexpr (FP8) { _Pragma("unroll") for (int m = 0; m < 4; ++m) dst##8[m] = ld32(lds + PG8_SA(b, h) + aoff + m * 2048); } \
        else { _Pragma("unroll") for (int m = 0; m < 4; ++m) _Pragma("unroll") for (int k = 0; k < 2; ++k) dst[m][k] = *(const LAS bf16x8*)(lds + PG8_SA(b, h) + aoff + m * 2048 + k * 1024); } } while (0)
#define PG8_LDB(dst, b, h) do { if constexpr (FP8) { _Pragma("unroll") for (int n = 0; n < 2; ++n) dst##8[n] = ld32(lds + PG8_SB(b, h) + boff + n * 2048); } \
        else { _Pragma("unroll") for (int n = 0; n < 2; ++n) _Pragma("unroll") for (int k = 0; k < 2; ++k) dst[n][k] = *(const LAS bf16x8*)(lds + PG8_SB(b, h) + boff + n * 2048 + k * 1024); } } while (0)
#define PG8_MMA(ai, bj, At, Bt) do { __builtin_amdgcn_s_setprio(1); \
        if constexpr (FP8) { _Pragma("unroll") for (int m = 0; m < 4; ++m) _Pragma("unroll") for (int n = 0; n < 2; ++n) \
            asm volatile("v_mfma_scale_f32_16x16x128_f8f6f4 %0, %1, %2, %0, %3, %4 op_sel_hi:[0,0,0]" : "+v"(acc[ai][bj][m][n]) : "v"(Bt##8[n]), "v"(At##8[m]), "v"((bj) ? sc_u : sc_w), "v"(sc_x)); } \
        else { _Pragma("unroll") for (int m = 0; m < 4; ++m) _Pragma("unroll") for (int n = 0; n < 2; ++n) _Pragma("unroll") for (int k = 0; k < 2; ++k) \
            acc[ai][bj][m][n] = __builtin_amdgcn_mfma_f32_16x16x32_bf16(Bt[n][k], At[m][k], acc[ai][bj][m][n], 0, 0, 0); } \
        __builtin_amdgcn_s_setprio(0); } while (0)
#define PG8_WAIT_V(n) asm volatile("s_waitcnt vmcnt(" #n ")" ::: "memory")
#define PG8_WAIT_L(n) asm volatile("s_waitcnt lgkmcnt(" #n ")" ::: "memory")
#define PG8_BAR __builtin_amdgcn_s_barrier()
#define PG8_SCHED __builtin_amdgcn_sched_barrier(0)
    Unit cur, nxt; int ui = 0;
    if (!S.next(0, cur)) return;
    const LAS unsigned char* zlds = lds + (ZERO_OFF - RING_OFF);
    f32x4 acc[2][2][4][2];
#pragma unroll
    for (int a = 0; a < 2; ++a)
#pragma unroll
        for (int b = 0; b < 2; ++b)
#pragma unroll
            for (int m = 0; m < 4; ++m)
#pragma unroll
                for (int n = 0; n < 2; ++n) acc[a][b][m][n] = (f32x4){0.f, 0.f, 0.f, 0.f};
    bf16x8 At[4][2], B0[2][2], B1[2][2];
    v8i At8[4], B08[2], B18[2];
    int sc_w = 0x7A7A7A7A, sc_x = g.sx, sc_u = g.su; asm volatile("" : "+v"(sc_w), "+v"(sc_x), "+v"(sc_u));
    unsigned cofs[2][2], nofs[2][2];
#define PG8_ROWOFS(dst, pm_) do { int t_[2][2];                                    \
        _Pragma("unroll") for (int h_ = 0; h_ < 2; ++h_) _Pragma("unroll") for (int i_ = 0; i_ < 2; ++i_) { int R_, C_; stage_rc(tid * 16 + i_ * 8192, R_, C_); t_[h_][i_] = rowidx[(pm_) * BM + h_ * HALF + R_]; } \
        asm volatile("" ::: "memory"); \
        _Pragma("unroll") for (int h_ = 0; h_ < 2; ++h_) _Pragma("unroll") for (int i_ = 0; i_ < 2; ++i_) { int R_, C_; stage_rc(tid * 16 + i_ * 8192, R_, C_); \
        const int u_ = t_[h_][i_] < 0 ? 0 : t_[h_][i_]; dst[h_][i_] = (unsigned)u_ * (unsigned)rb + 2u * (unsigned)C_; } } while (0)
#define PG8_STAGE_A(bufoff, kb, h, ofs) do { if constexpr (GATHER) { PG8_STAGE(bufoff, (const char*)g.A + (kb), ofs); } else { PG8_STAGE(bufoff, (kb) + (h) * hstep, voffA); } } while (0)
    const char* cA = (const char*)g.A + (size_t)cur.pm * tstep; const char* cB = (const char*)g.Bt + (size_t)cur.pn * tstep;
    if constexpr (GATHER) { PG8_ROWOFS(cofs, cur.pm); }
    if constexpr (GATHER) {
        PG8_STAGE(PG8_SB(0, 0), cB, voffB); PG8_STAGE(PG8_SB(0, 1), cB + hstep, voffB); PG8_STAGE(PG8_SA(0, 0), (const char*)g.A, cofs[0]); PG8_STAGE(PG8_SA(0, 1), (const char*)g.A, cofs[1]);
    } else {
        PG8_STAGE(PG8_SB(0, 0), cB, voffB); PG8_STAGE(PG8_SB(0, 1), cB + hstep, voffB); PG8_STAGE(PG8_SA(0, 0), cA, voffA); PG8_STAGE(PG8_SA(0, 1), cA + hstep, voffA);
    }
    if (wr == 1) PG8_BAR;
    PG8_WAIT_V(2); PG8_BAR;
    if constexpr (GATHER) {
        PG8_STAGE(PG8_SB(1, 0), cB + kstep, voffB); PG8_STAGE(PG8_SA(1, 0), (const char*)g.A + kstep, cofs[0]); PG8_STAGE(PG8_SB(1, 1), cB + hstep + kstep, voffB);
    } else {
        PG8_STAGE(PG8_SB(1, 0), cB + kstep, voffB); PG8_STAGE(PG8_SA(1, 0), cA + kstep, voffA); PG8_STAGE(PG8_SB(1, 1), cB + hstep + kstep, voffB);
    }
    PG8_WAIT_V(6); PG8_BAR;
    for (;;) {
        const bool has_next = S.next(ui + 1, nxt);
        const char* nA = has_next ? (const char*)g.A + (size_t)nxt.pm * tstep : cA; const char* nB = has_next ? (const char*)g.Bt + (size_t)nxt.pn * tstep : cB;
        if constexpr (GATHER) { if (has_next) { PG8_ROWOFS(nofs, nxt.pm); } else { nofs[0][0] = cofs[0][0]; nofs[0][1] = cofs[0][1]; nofs[1][0] = cofs[1][0]; nofs[1][1] = cofs[1][1]; } }
        for (int t = 0; t < nt; t += 2) {
            const bool last = (t == nt - 2);
            const char* b2 = last ? nB : cB + (size_t)(t + 2) * kstep; const char* b3 = b2 + kstep;
            if constexpr (GATHER) {
                const size_t k1 = (size_t)(t + 1) * kstep, k2 = last ? (size_t)0 : (size_t)(t + 2) * kstep, k3 = k2 + kstep;
                unsigned o2h0[2], o2h1[2];
                o2h0[0] = last ? nofs[0][0] : cofs[0][0]; o2h0[1] = last ? nofs[0][1] : cofs[0][1]; o2h1[0] = last ? nofs[1][0] : cofs[1][0]; o2h1[1] = last ? nofs[1][1] : cofs[1][1];
                PG8_LDB(B0, 0, 0); PG8_LDB(B1, 0, 1); PG8_SCHED; PG8_LDA(At, 0, 0); PG8_STAGE(PG8_SA(1, 1), (const char*)g.A + k1, cofs[1]);
                PG8_WAIT_V(8); PG8_WAIT_L(0); PG8_BAR; PG8_MMA(0, 0, At, B0); PG8_MMA(0, 1, At, B1); PG8_BAR; PG8_SCHED;
                PG8_LDA(At, 0, 1); PG8_STAGE(PG8_SB(0, 0), b2, voffB); PG8_STAGE(PG8_SB(0, 1), b2 + hstep, voffB); PG8_STAGE(PG8_SA(0, 0), (const char*)g.A + k2, o2h0);
                PG8_WAIT_V(8); PG8_WAIT_L(0); PG8_BAR; PG8_MMA(1, 0, At, B0); PG8_MMA(1, 1, At, B1); PG8_BAR; PG8_SCHED;
                PG8_LDB(B0, 1, 0); PG8_LDB(B1, 1, 1); PG8_SCHED; PG8_LDA(At, 1, 0); PG8_STAGE(PG8_SA(0, 1), (const char*)g.A + k2, o2h1);
                PG8_WAIT_V(8); PG8_WAIT_L(0); PG8_BAR; PG8_MMA(0, 0, At, B0); PG8_MMA(0, 1, At, B1); PG8_BAR; PG8_SCHED;
                PG8_LDA(At, 1, 1); PG8_STAGE(PG8_SB(1, 0), b3, voffB); PG8_STAGE(PG8_SB(1, 1), b3 + hstep, voffB); PG8_STAGE(PG8_SA(1, 0), (const char*)g.A + k3, o2h0);
                PG8_WAIT_V(8); PG8_WAIT_L(0); PG8_BAR; PG8_MMA(1, 0, At, B0); PG8_MMA(1, 1, At, B1); PG8_BAR; PG8_SCHED;
            } else {
                const char* a1 = cA + (size_t)(t + 1) * kstep;
                const char* a2 = last ? nA : cA + (size_t)(t + 2) * kstep;
                const char* a3 = a2 + kstep;
                PG8_LDB(B0, 0, 0); PG8_LDB(B1, 0, 1); PG8_SCHED; PG8_LDA(At, 0, 0); PG8_STAGE(PG8_SA(1, 1), a1 + hstep, voffA);
                PG8_WAIT_V(8); PG8_WAIT_L(0); PG8_BAR; PG8_MMA(0, 0, At, B0); PG8_MMA(0, 1, At, B1); PG8_BAR; PG8_SCHED;
                PG8_LDA(At, 0, 1); PG8_STAGE(PG8_SB(0, 0), b2, voffB); PG8_STAGE(PG8_SB(0, 1), b2 + hstep, voffB); PG8_STAGE(PG8_SA(0, 0), a2, voffA);
                PG8_WAIT_V(8); PG8_WAIT_L(0); PG8_BAR; PG8_MMA(1, 0, At, B0); PG8_MMA(1, 1, At, B1); PG8_BAR; PG8_SCHED;
                PG8_LDB(B0, 1, 0); PG8_LDB(B1, 1, 1); PG8_SCHED; PG8_LDA(At, 1, 0); PG8_STAGE(PG8_SA(0, 1), a2 + hstep, voffA);
                PG8_WAIT_V(8); PG8_WAIT_L(0); PG8_BAR; PG8_MMA(0, 0, At, B0); PG8_MMA(0, 1, At, B1); PG8_BAR; PG8_SCHED;
                PG8_LDA(At, 1, 1); PG8_STAGE(PG8_SB(1, 0), b3, voffB); PG8_STAGE(PG8_SB(1, 1), b3 + hstep, voffB); PG8_STAGE(PG8_SA(1, 0), a3, voffA);
                PG8_WAIT_V(8); PG8_WAIT_L(0); PG8_BAR; PG8_MMA(1, 0, At, B0); PG8_MMA(1, 1, At, B1); PG8_BAR; PG8_SCHED;
            }
        }
        if constexpr (ALIGN_EPI) { if (wr == 0) PG8_BAR; }
        if constexpr (FP8) {
            asm volatile("s_nop 15\n\ts_nop 15"
                : "+v"(acc[1][0][0][0]), "+v"(acc[1][0][0][1]), "+v"(acc[1][0][1][0]), "+v"(acc[1][0][1][1]), "+v"(acc[1][0][2][0]), "+v"(acc[1][0][2][1]), "+v"(acc[1][0][3][0]), "+v"(acc[1][0][3][1]),
                  "+v"(acc[1][1][0][0]), "+v"(acc[1][1][0][1]), "+v"(acc[1][1][1][0]), "+v"(acc[1][1][1][1]), "+v"(acc[1][1][2][0]), "+v"(acc[1][1][2][1]), "+v"(acc[1][1][3][0]), "+v"(acc[1][1][3][1])); }
        E(acc, cur, wr, wc, fr, fq);
        if (!has_next) break;
        { int zo = 0; asm volatile("" : "+v"(zo));
          const LAS unsigned char* zp = zlds + zo;
#pragma unroll
          for (int a = 0; a < 2; ++a)
#pragma unroll
            for (int b = 0; b < 2; ++b)
#pragma unroll
                for (int m = 0; m < 4; ++m)
#pragma unroll
                    for (int n = 0; n < 2; ++n) acc[a][b][m][n] = *(const LAS f32x4*)(zp + (((a * 2 + b) * 4 + m) * 2 + n) * 16); }
        cur = nxt; cA = nA; cB = nB; ++ui;
        if constexpr (GATHER) { cofs[0][0] = nofs[0][0]; cofs[0][1] = nofs[0][1]; cofs[1][0] = nofs[1][0]; cofs[1][1] = nofs[1][1]; }
        if constexpr (ALIGN_EPI) { if (wr == 1) PG8_BAR; }
    }
    PG8_WAIT_V(0);
    if constexpr (!ALIGN_EPI) { if (wr == 0) PG8_BAR; }
    PG8_BAR;
#undef PG8_STAGE_A
#undef PG8_ROWOFS
#undef PG8_SA
#undef PG8_SB
#undef PG8_STAGE
#undef PG8_LDA
#undef PG8_LDB
#undef PG8_MMA
#undef PG8_WAIT_V
#undef PG8_WAIT_L
#undef PG8_BAR
#undef PG8_SCHED
}

typedef const f32x4 (&AccRef)[2][2][4][2];
__device__ __forceinline__ float row_rstd(const float* ssq, int row) {
    const f32x4* p = (const f32x4*)(ssq + (size_t)row * 16); const f32x4 a = p[0], b = p[1], c = p[2], d = p[3];
    const float s = (((a.x + a.y) + (a.z + a.w)) + ((b.x + b.y) + (b.z + b.w))) + (((c.x + c.y) + (c.z + c.w)) + ((d.x + d.y) + (d.z + d.w)));
    return 1.f / sqrtf(s * (1.f / DM) + NORM_EPS);
}
__device__ __forceinline__ void rows_rstd(const float* ssq, int row0, int fq, float (&rs)[8]) {
    f32x4 p[8];
#pragma unroll
    for (int i = 0; i < 8; ++i) p[i] = *(const f32x4*)(ssq + (size_t)(row0 + (i >> 2) * HALF + (i & 3) * 16) * 16 + 4 * fq);
    asm volatile("" ::: "memory");
#pragma unroll
    for (int i = 0; i < 8; ++i) { float s = (p[i].x + p[i].y) + (p[i].z + p[i].w); s = xor32_sum(xor16_sum(s)); rs[i] = __builtin_amdgcn_rsqf(s * (1.f / DM) + NORM_EPS); }
}
struct EpiProj {
    bf16_t* Q; unsigned char* KT; unsigned char* VT; const float* ssq;
    __device__ __forceinline__ void operator()(AccRef acc, const Unit& u, int wr, int wc, int fr, int fq) const {
        const int row0 = u.pm * BM + wr * 64 + fr, colt = wc * 32 + 8 * fq;
        const int pn = u.pn, sect = pn >> 1;
        const int kind = sect % 3, gbase = sect >= 3 ? 4 : 0, c0 = (pn & 1) * 256 + colt;
        float rsv[8]; rows_rstd(ssq, row0, fq, rsv);
        auto body = [&](auto kind_tag) __attribute__((always_inline)) {
            constexpr int KIND = decltype(kind_tag)::value;
            const float sc = KIND == 0 ? C2 : 1.f;
#pragma unroll
            for (int ai = 0; ai < 2; ++ai)
#pragma unroll
                for (int m = 0; m < 4; ++m) { const int row = row0 + ai * HALF + m * 16; const int bT = row >> 6, key = row & 63;
                    const float rs = sc * rsv[ai * 4 + m];
#pragma unroll
                    for (int bj = 0; bj < 2; ++bj) { const f32x4 v0 = acc[ai][bj][m][0] * rs, v1 = acc[ai][bj][m][1] * rs;
                        u32x4 w; w.x = cvt_pk_bf16(v0[0], v0[1]); w.y = cvt_pk_bf16(v0[2], v0[3]); w.z = cvt_pk_bf16(v1[0], v1[1]); w.w = cvt_pk_bf16(v1[2], v1[3]);
                        const int cc = c0 + bj * HALF;
                        if constexpr (KIND == 0) *(u32x4*)(Q + (size_t)row * DM + (gbase ? 512 : 0) + cc) = w;
                        else if constexpr (KIND == 1) *(u32x4*)(KT + ((size_t)(((bT * 8 + gbase + (cc >> 7)) * 2 + ((cc >> 6) & 1)) * 8 + ((cc >> 3) & 7)) << 10) + key * 16) = w;
                        else *(u32x4*)(VT + ((size_t)(bT * 8 + gbase + (cc >> 7)) << 14) + (((cc & 127) >> 5) << 12) + key * 64 + (cc & 31) * 2) = w; } }
        };
        if (kind == 0) body(std::integral_constant<int, 0>{}); else if (kind == 1) body(std::integral_constant<int, 1>{}); else body(std::integral_constant<int, 2>{});
    }
};
template <bool A8 = false>
struct EpiRes {
    bf16_t* X; float* ssq; unsigned char* a8 = nullptr;
    __device__ __forceinline__ void operator()(AccRef acc, const Unit& u, int wr, int wc, int fr, int fq) const {
        const int row0 = u.pm * BM + wr * 64 + fr, col0 = u.pn * BM + wc * 32 + 8 * fq;
#pragma unroll
        for (int ai = 0; ai < 2; ++ai) {
        u32x4 xr[4][2];
#pragma unroll
            for (int m = 0; m < 4; ++m)
#pragma unroll
                for (int bj = 0; bj < 2; ++bj) xr[m][bj] = *(const u32x4*)(X + (size_t)(row0 + ai * HALF + m * 16) * DM + col0 + bj * HALF);
        asm volatile("" ::: "memory");
#pragma unroll
            for (int m = 0; m < 4; ++m) { const int row = row0 + ai * HALF + m * 16; const size_t off = (size_t)row * DM + col0; float sq = 0.f;
#pragma unroll
                for (int bj = 0; bj < 2; ++bj) { const u32x4 r = xr[m][bj];
                    const f32x4 x0 = f32x4{bf_lo(r.x), bf_hi(r.x), bf_lo(r.y), bf_hi(r.y)} + acc[ai][bj][m][0], x1 = f32x4{bf_lo(r.z), bf_hi(r.z), bf_lo(r.w), bf_hi(r.w)} + acc[ai][bj][m][1];
                    u32x4 w; w.x = cvt_pk_bf16(x0[0], x0[1]); w.y = cvt_pk_bf16(x0[2], x0[3]); w.z = cvt_pk_bf16(x1[0], x1[1]); w.w = cvt_pk_bf16(x1[2], x1[3]);
                    *(u32x4*)(X + off + bj * HALF) = w;
                    if constexpr (A8) { u32x2 w8; w8.x = pk4_fp8(8.f * x0[0], 8.f * x0[1], 8.f * x0[2], 8.f * x0[3]); w8.y = pk4_fp8(8.f * x1[0], 8.f * x1[1], 8.f * x1[2], 8.f * x1[3]); *(u32x2*)(a8 + off + bj * HALF) = w8; }
                    sq += ((x0.x * x0.x + x0.y * x0.y) + (x0.z * x0.z + x0.w * x0.w)) + ((x1.x * x1.x + x1.y * x1.y) + (x1.z * x1.z + x1.w * x1.w)); }
                sq = xor32_sum(xor16_sum(sq));
                if (fq == 0) ssq[(size_t)row * 16 + u.pn * 4 + wc] = sq; }
        asm volatile("" ::: "memory");
        }
    }
};
__device__ __forceinline__ float silu_mul(float gp, float up) { return gp * up * __builtin_amdgcn_rcpf(1.f + __builtin_amdgcn_exp2f(gp)); }
template <bool NORM, bool F8>
struct EpiSwiGLU {
    bf16_t* H; int ldh; int nnl; const float* ssq;
    __device__ __forceinline__ void operator()(AccRef acc, const Unit& u, int wr, int wc, int fr, int fq) const {
        const int row0 = u.pm * BM + wr * 64 + fr, col0 = (u.pn % nnl) * HALF + wc * 32 + 8 * fq;
        float rsv[8];
        if constexpr (NORM) rows_rstd(ssq, row0, fq, rsv);
#pragma unroll
        for (int ai = 0; ai < 2; ++ai)
#pragma unroll
            for (int m = 0; m < 4; ++m) { bf16_t* rowp = H + (size_t)(row0 + ai * HALF + m * 16) * ldh + col0;
                f32x4 g0 = acc[ai][0][m][0], g1 = acc[ai][0][m][1], u0 = acc[ai][1][m][0], u1 = acc[ai][1][m][1];
                if constexpr (NORM) { const float rs = rsv[ai * 4 + m], ru = F8 ? 8.f * rs : rs; g0 = g0 * rs; g1 = g1 * rs; u0 = u0 * ru; u1 = u1 * ru; }
                const float h0 = silu_mul(g0[0], u0[0]), h1 = silu_mul(g0[1], u0[1]), h2 = silu_mul(g0[2], u0[2]), h3 = silu_mul(g0[3], u0[3]), h4 = silu_mul(g1[0], u1[0]), h5 = silu_mul(g1[1], u1[1]), h6 = silu_mul(g1[2], u1[2]), h7 = silu_mul(g1[3], u1[3]);
                if constexpr (F8) { u32x2 w8; w8.x = pk4_fp8(h0, h1, h2, h3); w8.y = pk4_fp8(h4, h5, h6, h7);
                    *(u32x2*)((unsigned char*)H + (size_t)(row0 + ai * HALF + m * 16) * ldh + col0) = w8; }
                else { u32x4 w; w.x = cvt_pk_bf16(h0, h1); w.y = cvt_pk_bf16(h2, h3); w.z = cvt_pk_bf16(h4, h5); w.w = cvt_pk_bf16(h6, h7);
                    *(u32x4*)rowp = w; } }
    }
};
struct EpiMoeDown {
    bf16_t* X; const int* rtok; const float* rgate; float gsc;
    __device__ __forceinline__ void operator()(AccRef acc, const Unit& u, int wr, int wc, int fr, int fq) const {
        const int row0 = u.pm * BM + wr * 64 + fr, col0 = (u.pn & 3) * BM + wc * 32 + 8 * fq;
        int tk[8]; float gv[8];
#pragma unroll
        for (int i = 0; i < 8; ++i) { const int r = row0 + (i >> 2) * HALF + (i & 3) * 16; tk[i] = rtok[r]; gv[i] = rgate[r]; }
        asm volatile("" ::: "memory");
        u32x4 xr[8][2];
#pragma unroll
        for (int i = 0; i < 8; ++i) { const bf16_t* xq = X + (size_t)(tk[i] < 0 ? 0 : tk[i]) * DM + col0;
            xr[i][0] = *(const u32x4*)xq; xr[i][1] = *(const u32x4*)(xq + HALF); }
        asm volatile("" ::: "memory");
        __builtin_amdgcn_s_waitcnt(0x0F70);
#pragma unroll
        for (int ai = 0; ai < 2; ++ai)
#pragma unroll
            for (int m = 0; m < 4; ++m) { const int tok = tk[ai * 4 + m]; const float gt = gv[ai * 4 + m] * gsc;
                if (tok >= 0) { bf16_t* xp = X + (size_t)tok * DM + col0;
#pragma unroll
                    for (int bj = 0; bj < 2; ++bj) { const u32x4 r = xr[ai * 4 + m][bj];
                        const f32x4 x0 = f32x4{bf_lo(r.x), bf_hi(r.x), bf_lo(r.y), bf_hi(r.y)} + acc[ai][bj][m][0] * gt, x1 = f32x4{bf_lo(r.z), bf_hi(r.z), bf_lo(r.w), bf_hi(r.w)} + acc[ai][bj][m][1] * gt;
                        u32x4 w; w.x = cvt_pk_bf16(x0[0], x0[1]); w.y = cvt_pk_bf16(x0[2], x0[3]); w.z = cvt_pk_bf16(x1[0], x1[1]); w.w = cvt_pk_bf16(x1[2], x1[3]);
                        *(u32x4*)(xp + bj * HALF) = w; } } }
    }
};
}

#define XB_TMO      128
#define XB_XCNT(j)  (256  + 64 * (j))
#define XB_XSUB(j)  (1280 + 64 * (j))
#define XB_XGEN(j)  (2304 + 64 * (j))
#define XB_TOP      3328
#define XB_TOPGEN   3392
#define XCD_BAR_WORDS 3456
static_assert((size_t)(CW_BAR + XCD_BAR_WORDS) * 4 <= CTL_ZERO_BYTES, "the per-call memset covers every control word");
#define XB_SPIN_CAP (1u << 20)

__device__ __forceinline__ unsigned xb_ld(unsigned* p)              { return __hip_atomic_load(p, __ATOMIC_RELAXED, __HIP_MEMORY_SCOPE_AGENT); }
__device__ __forceinline__ unsigned xb_add(unsigned* p, unsigned v) { return __hip_atomic_fetch_add(p, v, __ATOMIC_RELAXED, __HIP_MEMORY_SCOPE_AGENT); }
__device__ __forceinline__ unsigned xb_xcc_id() { return (unsigned)__builtin_amdgcn_s_getreg((3 << 11) | 20) & 0xFu; }
#define XB_SPIN(cond, bar) do { unsigned _sp = 0; while (cond) { __builtin_amdgcn_s_sleep(1); \
    if ((++_sp & 255u) == 0u) { if (xb_ld(&(bar)[XB_TMO])) break; if (_sp > XB_SPIN_CAP) { atomicAdd(&(bar)[XB_TMO], 1u); break; } } } } while (0)

struct XcdBarrier { unsigned* bar; unsigned x; volatile LAS unsigned* st; };

__device__ __forceinline__ XcdBarrier xcd_barrier_post(unsigned* bar, volatile LAS unsigned* st) {
    XcdBarrier b; b.bar = bar; b.x = xb_xcc_id(); b.st = st;
    if (threadIdx.x == 0) (void)xb_add(&bar[XB_XCNT(b.x)], 1u);
    return b;
}
__device__ __forceinline__ void xcd_barrier_complete(unsigned* bar, unsigned x, unsigned& nloc, unsigned& nx) {
    const unsigned G = gridDim.x * gridDim.y * gridDim.z;
    unsigned sum, cnt, mine, sp = 0u;
    for (;;) {
        sum = 0u; cnt = 0u; mine = 0u;
#pragma unroll
        for (unsigned j = 0; j < 16; ++j) { const unsigned c = xb_ld(&bar[XB_XCNT(j)]); sum += c; cnt += (c > 0u) ? 1u : 0u; mine = (j == x) ? c : mine; }
        if (sum == G) break;
        __builtin_amdgcn_s_sleep(1);
        if ((++sp & 255u) == 0u) { if (xb_ld(&bar[XB_TMO])) break; if (sp > XB_SPIN_CAP) { atomicAdd(&bar[XB_TMO], 1u); break; } }
    }
    nloc = mine > 0u ? mine : 1u; nx = cnt > 0u ? cnt : 1u;
}
__device__ __forceinline__ void xcd_barrier(const XcdBarrier& b) {
    asm volatile("s_waitcnt vmcnt(0)" ::: "memory");
    __syncthreads();
    if (threadIdx.x == 0) {
        unsigned* bar = b.bar;
        __builtin_amdgcn_s_waitcnt(0);
        unsigned nloc = b.st[0], nx = b.st[1];
        if (nloc == 0u) { xcd_barrier_complete(bar, b.x, nloc, nx); b.st[0] = nloc; b.st[1] = nx; }
        const unsigned old = xb_add(&bar[XB_XSUB(b.x)], 1u);
        const unsigned gen = old / nloc;
        if (old + 1u == (gen + 1u) * nloc) {
            __builtin_amdgcn_fence(__ATOMIC_RELEASE, "agent");
            asm volatile("s_waitcnt vmcnt(0)" ::: "memory");
            const unsigned og = xb_add(&bar[XB_TOP], 1u);
            const unsigned tg = og / nx;
            if (og + 1u == (tg + 1u) * nx) xb_add(&bar[XB_TOPGEN], 1u);
            else XB_SPIN(xb_ld(&bar[XB_TOPGEN]) == tg, bar);
            __builtin_amdgcn_fence(__ATOMIC_ACQUIRE, "agent");
            xb_add(&bar[XB_XGEN(b.x)], 1u);
            asm volatile("s_waitcnt vmcnt(0)" ::: "memory");
        } else {
            XB_SPIN(xb_ld(&bar[XB_XGEN(b.x)]) == gen, bar);
            __builtin_amdgcn_fence(__ATOMIC_ACQUIRE, "agent");
            asm volatile("s_waitcnt vmcnt(0)" ::: "memory");
        }
    }
    __syncthreads();
}

__device__ __forceinline__ void transpose_item(const float* W, int N, bf16_t* WT, int ldk, int dst_row0, LAS float* scr, int k0, int n0, int lane, const float* kgain, float ws) {
    f32x4 v[8];
    const float* src = W + (size_t)(k0 + (lane >> 3)) * N + n0 + (lane & 7) * 4;
#pragma unroll
    for (int i = 0; i < 8; ++i) v[i] = __builtin_nontemporal_load((const GAS f32x4*)(src + (size_t)(8 * i) * N));
#pragma unroll
    for (int i = 0; i < 8; ++i) { LAS float* d = scr + (8 * i + (lane >> 3)) * 33 + (lane & 7) * 4; d[0] = v[i].x; d[1] = v[i].y; d[2] = v[i].z; d[3] = v[i].w; }
    LDS_WAIT(); asm volatile("" ::: "memory");
    const int c = lane & 7;
    f32x4 ga = {ws, ws, ws, ws}, gb = ga;
    if (kgain) { ga = *(const f32x4*)(kgain + k0 + 8 * c) * ws; gb = *(const f32x4*)(kgain + k0 + 8 * c + 4) * ws; }
#pragma unroll
    for (int j = 0; j < 4; ++j) { const int n = (lane >> 3) + 8 * j; const LAS float* s = scr + (8 * c) * 33 + n;
        u32x4 o; o.x = pk2(s[0 * 33] * ga.x, s[1 * 33] * ga.y); o.y = pk2(s[2 * 33] * ga.z, s[3 * 33] * ga.w); o.z = pk2(s[4 * 33] * gb.x, s[5 * 33] * gb.y); o.w = pk2(s[6 * 33] * gb.z, s[7 * 33] * gb.w);
        *(GAS u32x4*)(WT + (size_t)(dst_row0 + n) * ldk + k0 + 8 * c) = o; }
    LDS_WAIT(); asm volatile("" ::: "memory");
}
__device__ __forceinline__ void transpose_item8(const float* W, int N, unsigned char* WT, int ldk, int dst_row0, LAS float* scr, int k0, int n0, int lane, float wscale, const float* kgain) {
    f32x4 v[16];
    const float* src = W + (size_t)(k0 + (lane >> 3)) * N + n0 + (lane & 7) * 4;
#pragma unroll
    for (int i = 0; i < 16; ++i) v[i] = __builtin_nontemporal_load((const GAS f32x4*)(src + (size_t)(8 * i) * N));
    const int c = lane & 7;
#pragma unroll
    for (int h = 0; h < 2; ++h) {
#pragma unroll
        for (int i = 0; i < 8; ++i) { LAS float* d = scr + (8 * i + (lane >> 3)) * 33 + (lane & 7) * 4; d[0] = v[8 * h + i].x; d[1] = v[8 * h + i].y; d[2] = v[8 * h + i].z; d[3] = v[8 * h + i].w; }
        LDS_WAIT(); asm volatile("" ::: "memory");
        f32x4 ga = {wscale, wscale, wscale, wscale}, gb = ga;
        if (kgain) { ga = *(const f32x4*)(kgain + k0 + 64 * h + 8 * c) * wscale; gb = *(const f32x4*)(kgain + k0 + 64 * h + 8 * c + 4) * wscale; }
#pragma unroll
        for (int j = 0; j < 4; ++j) { const int n = (lane >> 3) + 8 * j; const LAS float* s = scr + (8 * c) * 33 + n;
            u32x2 o; o.x = pk4_fp8(s[0 * 33] * ga.x, s[1 * 33] * ga.y, s[2 * 33] * ga.z, s[3 * 33] * ga.w); o.y = pk4_fp8(s[4 * 33] * gb.x, s[5 * 33] * gb.y, s[6 * 33] * gb.z, s[7 * 33] * gb.w);
            *(GAS u32x2*)(WT + (size_t)(dst_row0 + n) * ldk + k0 + 64 * h + 8 * c) = o; }
        LDS_WAIT(); asm volatile("" ::: "memory");
    }
}
__device__ __forceinline__ void transpose_matrix8(const float* W, int K, int N, unsigned char* WT, bool inter, int inter_off, LAS float* scr, int gw, int NGW, int lane, float wscale, int rot, const float* kgain = nullptr) {
    const int nblk = N / 32, items = (K / 128) * nblk;
    int w0 = gw - rot % NGW; if (w0 < 0) w0 += NGW;
    for (int it = w0; it < items; it += NGW) { const int kb = it / nblk, nb = it % nblk, n0 = 32 * nb;
        const int dr = inter ? ((n0 >> 7) * 256 + (n0 & 127) + inter_off) : n0;
        transpose_item8(W, N, WT, K, dr, scr, 128 * kb, n0, lane, wscale, kgain); }
}
__device__ __forceinline__ void transpose_matrix(const float* W, int K, int N, bf16_t* WT, bool inter, int inter_off, LAS float* scr, int gw, int NGW, int lane, const float* kgain, int rot, float ws = 1.f) {
    const int nblk = N / 32, items = (K / 64) * nblk;
    int w0 = gw - rot % NGW; if (w0 < 0) w0 += NGW;
    for (int it = w0; it < items; it += NGW) { const int kb = it / nblk, nb = it % nblk, n0 = 32 * nb;
        const int dr = inter ? ((n0 >> 7) * 256 + (n0 & 127) + inter_off) : n0;
        transpose_item(W, N, WT, K, dr, scr, 64 * kb, n0, lane, kgain, ws); }
}
__device__ __forceinline__ void load_row(const float* xrow, int lane, f32x4 (&v)[4]) {
    const GAS f32x4* xr = (const GAS f32x4*)xrow + lane;
#pragma unroll
    for (int j = 0; j < 4; ++j) v[j] = __builtin_nontemporal_load(xr + 64 * j);
}
template <bool NT = false>
__device__ __forceinline__ void load_row_bf(const bf16_t* xrow, int lane, u32x2 (&r)[4]) {
    const GAS u32x2* xr = (const GAS u32x2*)xrow + lane;
#pragma unroll
    for (int j = 0; j < 4; ++j) r[j] = NT ? __builtin_nontemporal_load(xr + 64 * j) : xr[64 * j];
}
__device__ __forceinline__ void cvt_row(const u32x2 (&r)[4], f32x4 (&v)[4]) {
#pragma unroll
    for (int j = 0; j < 4; ++j) v[j] = f32x4{bf_lo(r[j].x), bf_hi(r[j].x), bf_lo(r[j].y), bf_hi(r[j].y)};
}
__device__ __forceinline__ void norm_row(const float* g, int lane, f32x4 (&v)[4]) {
    asm volatile("" : "+s"(g));
    const GAS f32x4* gr = (const GAS f32x4*)g + lane;
    float s2 = 0.f;
#pragma unroll
    for (int j = 0; j < 4; ++j) s2 += (v[j].x * v[j].x + v[j].y * v[j].y) + (v[j].z * v[j].z + v[j].w * v[j].w);
    const float rstd = __builtin_amdgcn_rsqf(wave_sum(s2) * (1.f / DM) + NORM_EPS);
#pragma unroll
    for (int j = 0; j < 4; ++j) v[j] = v[j] * rstd * gr[64 * j];
}
__device__ __forceinline__ void norm_row_l(const LAS float* gl, int lane, f32x4 (&v)[4]) {
    const LAS f32x4* gr = (const LAS f32x4*)gl + lane;
    f32x4 gg[4];
#pragma unroll
    for (int j = 0; j < 4; ++j) gg[j] = gr[64 * j];
    float s2 = 0.f;
#pragma unroll
    for (int j = 0; j < 4; ++j) s2 += (v[j].x * v[j].x + v[j].y * v[j].y) + (v[j].z * v[j].z + v[j].w * v[j].w);
    const float rstd = __builtin_amdgcn_rsqf(wave_sum(s2) * (1.f / DM) + NORM_EPS);
#pragma unroll
    for (int j = 0; j < 4; ++j) v[j] = v[j] * rstd * gg[j];
}
__device__ __forceinline__ void rms_row(const float* xrow, const float* g, int lane, f32x4 (&v)[4]) { load_row(xrow, lane, v); norm_row(g, lane, v); }
__device__ __forceinline__ void store_row_bf16(bf16_t* orow, int lane, const f32x4 (&v)[4]) {
    GAS unsigned long long* o8 = (GAS unsigned long long*)orow + lane;
#pragma unroll
    for (int j = 0; j < 4; ++j) o8[64 * j] = (unsigned long long)pk2(v[j].x, v[j].y) | ((unsigned long long)pk2(v[j].z, v[j].w) << 32);
}

namespace att {
constexpr int BUFB = 32768, KIMG = 8192, VOFF = 16384;
constexpr int SCR_OFF = 3 * BUFB, FLAG_OFF = SCR_OFF + NWAVES * 256;
constexpr float THR = 8.f, SB_DONE = 7.5e-37f;
#ifndef ATT_LS_DIFF
#define ATT_LS_DIFF 1
#endif
#ifndef ATT_LS_SB
#define ATT_LS_SB 1
#endif
__device__ __forceinline__ int crow(int r, int hi) { return (r & 3) + 8 * (r >> 2) + 4 * hi; }
__device__ __forceinline__ f32x16 mfma32(bf16x8 a, bf16x8 b, f32x16 c) { return __builtin_amdgcn_mfma_f32_32x32x16_bf16(a, b, c, 0, 0, 0); }
typedef short v4i16_t __attribute__((ext_vector_type(4)));
__device__ __forceinline__ s16x4 vtr(const LAS unsigned char* p) { return __builtin_bit_cast(s16x4, __builtin_amdgcn_ds_read_tr16_b64_v4i16((LAS v4i16_t*)p)); }
__device__ __forceinline__ float max3f(float a, float b, float c) { return __builtin_fmaxf(__builtin_fmaxf(a, b), c); }
__device__ __forceinline__ unsigned cvtpk(float lo, float hi) { f32x2_t v = {lo, hi}; bf16x2_t b = __builtin_convertvector(v, bf16x2_t); return __builtin_bit_cast(unsigned, b); }
__device__ __forceinline__ float swap_max(float v) { auto rr = __builtin_amdgcn_permlane32_swap(__float_as_uint(v), __float_as_uint(v), false, false); return fmaxf(__uint_as_float(rr[0]), __uint_as_float(rr[1])); }
__device__ __forceinline__ float swap_sum(float v) { auto rr = __builtin_amdgcn_permlane32_swap(__float_as_uint(v), __float_as_uint(v), false, false); return __uint_as_float(rr[0]) + __uint_as_float(rr[1]); }

struct Params {
    const bf16_t* q; const unsigned char* kt; const unsigned char* vt; bf16_t* y;
    int goff;
    float lam, outscale;
};

#ifndef ATT_DMA_BUILTIN
#define ATT_DMA_BUILTIN 0
#endif
__device__ __forceinline__ void glds16(const void* gsrc, unsigned lds_dst) {
#if ATT_DMA_BUILTIN
    __builtin_amdgcn_global_load_lds((const unsigned*)gsrc, (LAS unsigned*)(uintptr_t)lds_dst, 16, 0, 0);
#else
    unsigned keep;
    asm volatile("s_mov_b32 %0, m0\n\ts_mov_b32 m0, %2\n\ts_nop 0\n\tglobal_load_lds_dwordx4 %1, off\n\ts_mov_b32 m0, %0" : "=&s"(keep) : "v"(gsrc), "s"(lds_dst) : "memory");
#endif
}

template <bool SBM>
__device__ __forceinline__ void unit(LAS unsigned char* lds, const Params& P, int b, int p, int qb, const int tid_in, bf16x8 (&qr)[4], const bool first, const bool has_next, const int nb, const int np, const int nqb) {
    int tid = tid_in; asm volatile("" : "+v"(tid));
    const int lane = tid & 63, r32 = lane & 31, hi = lane >> 5;
    const int wid = __builtin_amdgcn_readfirstlane(tid >> 6), c = wid >> 2, wq = wid & 3;
    const int q0 = qb * 128, qw = q0 + 32 * wq;
    const size_t rowbase = (size_t)b * SEQ;
    constexpr bool LS = SBM ? (ATT_LS_SB != 0) : (ATT_LS_DIFF != 0);
    static_assert(LS, "the tile loop reads V(j) at the start of X(j): only the lockstep schedule has it landed by then");
    const int qcol = (SBM ? 0 : 512) + p * 128 + c * 64, grp = (SBM ? 0 : 4) + p;
    constexpr int NB = SBM ? 2 : 4;
    LAS float* scr = (LAS float*)(lds + SCR_OFF) + wid * 64;
    volatile LAS int* flags = (volatile LAS int*)(lds + FLAG_OFF);
    const LAS float* tbl = (const LAS float*)(lds + TBL_OFF) + p * 132;
    const int NT = 2 * qb + 2;
    const unsigned char* kg = P.kt + ((size_t)((b * 64) * 8 + grp) << 14) + wid * 1024 + lane * 16;
    const unsigned char* vg = P.vt + ((size_t)((b * 64) * 8 + grp) << 14) + wid * 1024 + lane * 16;
    const unsigned lds0 = (unsigned)(uintptr_t)lds + (unsigned)wid * 1024u;
#define ATT_DMA_K(j_, b_) do { const size_t ro_ = (size_t)(NT - 1 - (j_)) << 17; const unsigned bo_ = lds0 + (unsigned)((b_) * BUFB); \
        glds16(kg + ro_, (unsigned)__builtin_amdgcn_readfirstlane(bo_)); glds16(kg + ro_ + 8192, (unsigned)__builtin_amdgcn_readfirstlane(bo_ + KIMG)); } while (0)
#define ATT_DMA_V(j_, b_) do { const size_t ro_ = (size_t)(NT - 1 - (j_)) << 17; const unsigned bo_ = lds0 + (unsigned)((b_) * BUFB + VOFF); \
        glds16(vg + ro_, (unsigned)__builtin_amdgcn_readfirstlane(bo_)); glds16(vg + ro_ + 8192, (unsigned)__builtin_amdgcn_readfirstlane(bo_ + 8192)); } while (0)
    if (first) { ATT_DMA_K(0, 0); ATT_DMA_V(0, 0);
      const bf16_t* qg = P.q + (rowbase + qw + r32) * DM + qcol + hi * 8;
#pragma unroll
      for (int d0 = 0; d0 < 4; ++d0) qr[d0] = *(const GAS bf16x8*)(qg + d0 * 16); }
    if (tid < 2 * NWAVES) flags[tid] = 0;
#pragma unroll
    for (int d0 = 0; d0 < 4; ++d0) asm volatile("" : "+v"(qr[d0]));
    asm volatile("s_waitcnt vmcnt(0) lgkmcnt(0)\n\ts_barrier" ::: "memory");
    ATT_DMA_K(1, 1); ATT_DMA_V(1, 1);
    f32x16 o[NB];
#pragma unroll
    for (int d = 0; d < NB; ++d) o[d] = f32x16{};
    float mref = 0.f, carry = 1.f; bool done = false, pend = false, fresh = true;
    f32x16 cc0 = f32x16{}, cc1 = f32x16{};
    f32x16 osum = f32x16{};
    u32x4 pw[4];
#pragma unroll
    for (int i = 0; i < 4; ++i) pw[i] = (u32x4){0u, 0u, 0u, 0u};
    s16x4 va[8];
#pragma unroll
    for (int i = 0; i < 8; ++i) va[i] = (s16x4){0, 0, 0, 0};
    const int vlane = ((lane >> 4) & 1) * 32 + (lane & 3) * 8 + (4 * hi + ((lane & 15) >> 2)) * 64 + (SBM ? c * 2 * 4096 : 0);
#define ATT_BAR(issued_) do { if (issued_) asm volatile("s_waitcnt vmcnt(4) lgkmcnt(0)\n\ts_barrier" ::: "memory"); else asm volatile("s_waitcnt vmcnt(0) lgkmcnt(0)\n\ts_barrier" ::: "memory"); } while (0)
#define ATT_FLAG_SET(h_) do { if constexpr (SBM) { if (lane == 0) flags[((h_) & 1) * NWAVES + wid] = (lastslot || done) ? 1 : 0; } } while (0)
#define ATT_FLAG_ALL(h_, res_) do { res_ = 0; if constexpr (SBM) { typedef int fl4_t __attribute__((ext_vector_type(4)));        \
        const LAS fl4_t* fp_ = (const LAS fl4_t*)(lds + FLAG_OFF) + ((h_) & 1) * 2; const fl4_t fa_ = fp_[0], fb_ = fp_[1]; const fl4_t fc_ = fa_ & fb_; res_ = (fc_.x & fc_.y) & (fc_.z & fc_.w); } } while (0)
    if (c == 1) __builtin_amdgcn_s_setprio(1);
    int b0 = 0;
    for (int j = 0; j < NT; ++j) {
        const int kt = NT - 1 - j, bo = b0 * BUFB, k0 = kt * 64, b2 = (b0 == 0) ? 2 : b0 - 1;
        const bool ahead = (j + 2 < NT);
        { if (ahead) { ATT_DMA_K(j + 2, b2); ATT_DMA_V(j + 2, b2); }
          pend = false;
          if (!done && k0 <= qw + 31) {
            pend = true;
            const LAS unsigned char* Kimg = lds + bo + c * KIMG + hi * 1024 + (r32 << 4);
            bf16x8 kf[8];
#pragma unroll
            for (int d0 = 0; d0 < 4; ++d0) { kf[2 * d0] = *(const LAS bf16x8*)(Kimg + d0 * 2048); kf[2 * d0 + 1] = *(const LAS bf16x8*)(Kimg + d0 * 2048 + 512); }
            { const LAS unsigned char* vb0 = lds + bo + VOFF + vlane;
              if constexpr (SBM) {
#pragma unroll
                for (int ks = 0; ks < 4; ++ks) { va[2 * ks] = vtr(vb0 + ks * 1024); va[2 * ks + 1] = vtr(vb0 + ks * 1024 + 512); }
              } }
            __builtin_amdgcn_sched_barrier(0);
            const int rel = qw + r32 - k0 - 4 * hi;
            f32x16 p0, p1;
            bool farb = false;
            if constexpr (!SBM) farb = (qw - (k0 + 63) >= 128);
            if constexpr (SBM) {
#pragma unroll
                for (int r = 0; r < 16; ++r) { p0[r] = 0.f; p1[r] = 0.f; }
#pragma unroll
                for (int d0 = 0; d0 < 4; ++d0) { p0 = mfma32(kf[2 * d0], qr[d0], p0); p1 = mfma32(kf[2 * d0 + 1], qr[d0], p1); }
            } else {
                if (!farb) {
                    const bool dmask = (k0 + 63 > qw);
                    const int sh = (227 - rel) & 3;
                    const LAS float* bt = (const LAS float*)(lds + BT_OFF) + (p * 4 + sh) * BT_N + (227 - rel - sh);
                    f32x4 rd[8];
#pragma unroll
                    for (int g = 0; g < 4; ++g) { rd[g] = *(const LAS f32x4*)(bt + 8 * g); rd[4 + g] = *(const LAS f32x4*)(bt + 32 + 8 * g); }
                    asm volatile("" ::: "memory");
                    const float nm = -mref;
                    if (dmask) {
#pragma unroll
                        for (int r = 0; r < 16; ++r) { const int kk = (r & 3) + 8 * (r >> 2);
                            cc0[r] = (rel - kk < 0) ? -INFINITY : nm + rd[r >> 2][r & 3]; cc1[r] = (rel - kk - 32 < 0) ? -INFINITY : nm + rd[4 + (r >> 2)][r & 3]; }
                    } else {
#pragma unroll
                        for (int r = 0; r < 16; ++r) { cc0[r] = nm + rd[r >> 2][r & 3]; cc1[r] = nm + rd[4 + (r >> 2)][r & 3]; }
                    }
                }
                p0 = mfma32(kf[0], qr[0], cc0); p1 = mfma32(kf[1], qr[0], cc1);
#pragma unroll
                for (int d0 = 1; d0 < 4; ++d0) { p0 = mfma32(kf[2 * d0], qr[d0], p0); p1 = mfma32(kf[2 * d0 + 1], qr[d0], p1); }
                if (!farb) { const float nm = -mref;
#pragma unroll
                    for (int r = 0; r < 16; ++r) { cc0[r] = nm; cc1[r] = nm; } }
            }
            __builtin_amdgcn_sched_barrier(0);
            if constexpr (SBM) {
                const bool needmask = (k0 + 63 >= qw);
                auto sb_weights = [&](auto mask_tag) __attribute__((always_inline)) {
                    constexpr bool MASK = decltype(mask_tag)::value;
                    float r0[16], r1[16];
#pragma unroll
                    for (int r = 0; r < 16; ++r) { const int kk = (r & 3) + 8 * (r >> 2);
                        const float e0 = __builtin_amdgcn_exp2f(p0[r]), e1 = __builtin_amdgcn_exp2f(p1[r]);
                        float s0 = __builtin_amdgcn_rcpf(1.f + e0), s1 = __builtin_amdgcn_rcpf(1.f + e1);
                        p0[r] = e0; p1[r] = e1;
                        if constexpr (MASK) { if (rel - kk <= 0) s0 = 1.f; if (rel - kk - 32 <= 0) s1 = 1.f; }
                        r0[r] = s0; r1[r] = s1; }
                    float Gs[16];
#pragma unroll
                    for (int g = 0; g < 4; ++g) { const float x0 = (r0[4 * g] * r0[4 * g + 1]) * (r0[4 * g + 2] * r0[4 * g + 3]), x1 = (r1[4 * g] * r1[4 * g + 1]) * (r1[4 * g + 2] * r1[4 * g + 3]);
                        auto ra = __builtin_amdgcn_permlane32_swap(__float_as_uint(x0), __float_as_uint(x0), false, false);
                        auto rb = __builtin_amdgcn_permlane32_swap(__float_as_uint(x1), __float_as_uint(x1), false, false);
                        Gs[2 * g] = __uint_as_float(ra[0]); Gs[2 * g + 1] = __uint_as_float(ra[1]); Gs[8 + 2 * g] = __uint_as_float(rb[0]); Gs[8 + 2 * g + 1] = __uint_as_float(rb[1]); }
                    float T[16]; T[15] = carry;
#pragma unroll
                    for (int jj = 14; jj >= 0; --jj) T[jj] = T[jj + 1] * Gs[jj + 1];
                    const float total = T[0] * Gs[0];
#pragma unroll
                    for (int g = 0; g < 4; ++g) {
                        float run0 = hi ? T[2 * g + 1] : T[2 * g], run1 = hi ? T[8 + 2 * g + 1] : T[8 + 2 * g];
#pragma unroll
                        for (int i = 3; i >= 0; --i) { const int r = 4 * g + i, kk = i + 8 * g;
                            run0 *= r0[r]; run1 *= r1[r];
                            float e0 = p0[r] * run0, e1 = p1[r] * run1;
                            if constexpr (MASK) { if (rel - kk <= 0) e0 = 0.f; if (rel - kk - 32 <= 0) e1 = 0.f; }
                            p0[r] = e0; p1[r] = e1; } }
                    carry = total;
                };
                if (needmask) sb_weights(std::true_type{}); else sb_weights(std::false_type{});
                done = __all(carry < SB_DONE);
            } else {
                float ra = max3f(p0[0], p0[1], p1[0]), rb = max3f(p0[2], p0[3], p1[1]); ra = max3f(ra, p1[2], p1[3]);
#pragma unroll
                for (int r = 4; r < 16; r += 4) { ra = max3f(ra, p0[r], p0[r + 1]); rb = max3f(rb, p0[r + 2], p0[r + 3]); ra = max3f(ra, p1[r], p1[r + 1]); rb = max3f(rb, p1[r + 2], p1[r + 3]); }
                const float rm = swap_max(__builtin_fmaxf(ra, rb));
                if (fresh || __any(rm > THR)) {
                    const float dl = fresh ? rm : fmaxf(rm, 0.f), al = fresh ? 1.f : __builtin_amdgcn_exp2f(-dl); mref += dl; osum[0] *= al;
#pragma unroll
                    for (int r = 0; r < 16; ++r) { p0[r] -= dl; p1[r] -= dl; cc0[r] = -mref; cc1[r] = -mref; }
                    if (!fresh) {
#pragma unroll
                        for (int d = 0; d < NB; ++d)
#pragma unroll
                            for (int r = 0; r < 16; ++r) o[d][r] *= al;
                    }
                    fresh = false;
                }
#pragma unroll
                for (int r = 0; r < 8; ++r) p0[r] = __builtin_amdgcn_exp2f(p0[r]);
            }
            pw[0] = (u32x4){cvtpk(p0[0], p0[1]), cvtpk(p0[2], p0[3]), cvtpk(p0[4], p0[5]), cvtpk(p0[6], p0[7])};
            if constexpr (SBM) {
            pw[1] = (u32x4){cvtpk(p0[8], p0[9]), cvtpk(p0[10], p0[11]), cvtpk(p0[12], p0[13]), cvtpk(p0[14], p0[15])};
            pw[2] = (u32x4){cvtpk(p1[0], p1[1]), cvtpk(p1[2], p1[3]), cvtpk(p1[4], p1[5]), cvtpk(p1[6], p1[7])};
            pw[3] = (u32x4){cvtpk(p1[8], p1[9]), cvtpk(p1[10], p1[11]), cvtpk(p1[12], p1[13]), cvtpk(p1[14], p1[15])};
            }
            const LAS unsigned char* vb = lds + bo + VOFF + vlane;
            s16x4 vbq[8];
            if constexpr (!SBM) {
#pragma unroll
                for (int d = 0; d < NB; ++d) { va[2 * d] = vtr(vb + d * 4096); va[2 * d + 1] = vtr(vb + d * 4096 + 512); }
                bf16x8 ones = (bf16x8){0x3F80, 0x3F80, 0x3F80, 0x3F80, 0x3F80, 0x3F80, 0x3F80, 0x3F80}; asm volatile("" : "+v"(ones));
#pragma unroll
                for (int ks = 0; ks < 4; ++ks) {
                    if (ks + 1 < 4) {
#pragma unroll
                        for (int d = 0; d < NB; ++d) { vbq[2 * d] = vtr(vb + d * 4096 + (ks + 1) * 1024); vbq[2 * d + 1] = vtr(vb + d * 4096 + (ks + 1) * 1024 + 512); }
                    }
                    __builtin_amdgcn_sched_barrier(0);
#pragma unroll
                    for (int d = 0; d < NB; ++d) { const s16x4 lo = va[2 * d], hh2 = va[2 * d + 1];
                        const bf16x8 vf = (bf16x8){lo[0], lo[1], lo[2], lo[3], hh2[0], hh2[1], hh2[2], hh2[3]};
                        o[d] = mfma32(vf, __builtin_bit_cast(bf16x8, pw[ks]), o[d]); }
                    osum = mfma32(ones, __builtin_bit_cast(bf16x8, pw[ks]), osum);
                    if (ks + 1 < 4) { float e[8];
#pragma unroll
                        for (int r = 0; r < 8; ++r) e[r] = __builtin_amdgcn_exp2f(ks == 0 ? p0[8 + r] : ks == 1 ? p1[r] : p1[8 + r]);
                        pw[ks + 1] = (u32x4){cvtpk(e[0], e[1]), cvtpk(e[2], e[3]), cvtpk(e[4], e[5]), cvtpk(e[6], e[7])}; }
                    __builtin_amdgcn_sched_barrier(0);
#pragma unroll
                    for (int i = 0; i < 8; ++i) va[i] = vbq[i];
                }
            } else
#pragma unroll
            for (int d = 0; d < NB; ++d) {
                if (d + 1 < NB) {
#pragma unroll
                    for (int ks = 0; ks < 4; ++ks) { vbq[2 * ks] = vtr(vb + (d + 1) * 4096 + ks * 1024); vbq[2 * ks + 1] = vtr(vb + (d + 1) * 4096 + ks * 1024 + 512); }
                }
                __builtin_amdgcn_sched_barrier(0);
#pragma unroll
                for (int ks = 0; ks < 4; ++ks) { const s16x4 lo = va[2 * ks], hh2 = va[2 * ks + 1];
                    const bf16x8 vf = (bf16x8){lo[0], lo[1], lo[2], lo[3], hh2[0], hh2[1], hh2[2], hh2[3]};
                    o[d] = mfma32(vf, __builtin_bit_cast(bf16x8, pw[ks]), o[d]); }
                __builtin_amdgcn_sched_barrier(0);
#pragma unroll
                for (int i = 0; i < 8; ++i) va[i] = vbq[i];
            }
          }
        }
        {
          const bool lastslot = (j == NT - 1); const int hg = j;
          ATT_FLAG_SET(hg); ATT_BAR(ahead);
          int brk; ATT_FLAG_ALL(hg, brk); if (brk) break;
        }
        b0 = (b0 == 2) ? 0 : b0 + 1;
    }
    __builtin_amdgcn_s_setprio(0);
#undef ATT_BAR
#undef ATT_FLAG_SET
#undef ATT_FLAG_ALL
#undef ATT_DMA_K
#undef ATT_DMA_V
    asm volatile("s_waitcnt vmcnt(0) lgkmcnt(0)\n\ts_barrier" ::: "memory");
    if (has_next) {
        const int qcn = (SBM ? 0 : 512) + np * 128 + c * 64, grn = (SBM ? 0 : 4) + np;
        const bf16_t* qg = P.q + ((size_t)nb * SEQ + nqb * 128 + 32 * wq + r32) * DM + qcn + hi * 8;
#pragma unroll
        for (int d0 = 0; d0 < 4; ++d0) qr[d0] = *(const GAS bf16x8*)(qg + d0 * 16);
        const size_t ro = ((size_t)((nb * 64) * 8 + grn) << 14) + wid * 1024 + lane * 16 + ((size_t)(2 * nqb + 1) << 17);
        glds16(P.kt + ro, (unsigned)__builtin_amdgcn_readfirstlane(lds0)); glds16(P.kt + ro + 8192, (unsigned)__builtin_amdgcn_readfirstlane(lds0 + KIMG));
        glds16(P.vt + ro, (unsigned)__builtin_amdgcn_readfirstlane(lds0 + VOFF)); glds16(P.vt + ro + 8192, (unsigned)__builtin_amdgcn_readfirstlane(lds0 + VOFF + 8192));
    }
    int lane_f = lane; asm volatile("" : "+v"(lane_f));
    const int n = lane_f & 31, hif = lane_f >> 5;
    const LAS float* gt = (const LAS float*)(lds + P.goff) + 4 * hif;
#define ATT_STORE_ROW(yrow_, scale_) do { _Pragma("unroll") for (int d = 0; d < NB; ++d) _Pragma("unroll") for (int gp = 0; gp < 2; ++gp) { \
        const f32x4 ga_ = *(const LAS f32x4*)(gt + 32 * d + 16 * gp), gb_ = *(const LAS f32x4*)(gt + 32 * d + 16 * gp + 8); \
        const unsigned x0_ = cvtpk(o[d][8 * gp] * (scale_) * ga_.x, o[d][8 * gp + 1] * (scale_) * ga_.y), x1_ = cvtpk(o[d][8 * gp + 2] * (scale_) * ga_.z, o[d][8 * gp + 3] * (scale_) * ga_.w); \
        const unsigned y0_ = cvtpk(o[d][8 * gp + 4] * (scale_) * gb_.x, o[d][8 * gp + 5] * (scale_) * gb_.y), y1_ = cvtpk(o[d][8 * gp + 6] * (scale_) * gb_.z, o[d][8 * gp + 7] * (scale_) * gb_.w); \
        auto s0_ = __builtin_amdgcn_permlane32_swap(x0_, y0_, false, false); auto s1_ = __builtin_amdgcn_permlane32_swap(x1_, y1_, false, false); \
        const unsigned a0_ = s0_[0], b0_ = s0_[1], a1_ = s1_[0], b1_ = s1_[1]; \
        *(u32x4*)((yrow_) + 32 * d + 16 * gp + 8 * hif) = (u32x4){a0_, a1_, b0_, b1_}; } } while (0)
    if constexpr (SBM) {
        const int hd = 2 * p + c;
        float s = 0.f;
#pragma unroll
        for (int d = 0; d < NB; ++d)
#pragma unroll
            for (int r = 0; r < 16; ++r) s += o[d][r] * o[d][r];
        const float ssr = __builtin_amdgcn_rsqf(xor32_sum(s) * (1.f / 64.f) + NORM_EPS);
        bf16_t* yrow = P.y + (rowbase + qw + n) * DM + hd * 64;
        ATT_STORE_ROW(yrow, ssr);
        asm volatile("s_waitcnt lgkmcnt(0)\n\ts_barrier" ::: "memory");
    } else {
        const float inv = 1.f / osum[0];
        LAS float* ex = (LAS float*)(lds + BUFB + wq * 16384) + lane;
        if (c == 1) {
#pragma unroll
            for (int d = 0; d < NB; ++d)
#pragma unroll
                for (int r = 0; r < 16; ++r) ex[(d * 16 + r) * 64] = o[d][r] * inv;
        }
        asm volatile("s_waitcnt lgkmcnt(0)\n\ts_barrier" ::: "memory");
        if (c == 0) {
            float s = 0.f;
#pragma unroll
            for (int d = 0; d < NB; ++d)
#pragma unroll
                for (int r = 0; r < 16; ++r) { const float v = o[d][r] * inv - P.lam * ex[(d * 16 + r) * 64]; o[d][r] = v; s += v * v; }
            const float ssr = P.outscale * __builtin_amdgcn_rsqf(xor32_sum(s) * (1.f / 128.f) + NORM_EPS);
            bf16_t* yrow = P.y + (rowbase + qw + n) * DM + 512 + p * 128;
            ATT_STORE_ROW(yrow, ssr);
        }
        asm volatile("s_waitcnt lgkmcnt(0)\n\ts_barrier" ::: "memory");
    }
#undef ATT_STORE_ROW
}
}

struct Args { const float* in[20]; float* out; unsigned char* ws; int ph_lo, ph_hi; };

__global__ void __launch_bounds__(NWAVES * 64, 2) mk_fwd(Args args) {
    extern __shared__ __attribute__((aligned(16))) unsigned char lds_raw[];
    LAS unsigned char* lds = (LAS unsigned char*)lds_raw;
    volatile LAS unsigned* MISC = (volatile LAS unsigned*)(lds + MISC_OFF);
    const int tid = threadIdx.x, wave = __builtin_amdgcn_readfirstlane(tid >> 6);
    const int Gk = gridDim.x; const int bx = blockIdx.x; const int vcu = (Gk % 8 == 0) ? (bx % 8) * (Gk / 8) + bx / 8 : bx;
    unsigned char* ws = args.ws;
    unsigned* ctl = (unsigned*)(ws + WS_CTL);
    for (int u = tid; u < (LDS_BYTES - LDSCTL_OFF) / 4; u += NWAVES * 64) ((LAS unsigned*)(lds + LDSCTL_OFF))[u] = 0u;
    __syncthreads();
    XcdBarrier bar = xcd_barrier_post(ctl + CW_BAR, MISC + 8);

    const int gw = vcu * NWAVES + wave;
    const int lo = args.ph_lo, hi = args.ph_hi;
    int ph = 0;
#define PH_ON (ph >= lo && ph < hi)
#define PH_END do { if (ph >= lo && ph + 1 < hi) xcd_barrier(bar); ++ph; } while (0)
#define PH_LOCALS int tl; asm volatile("v_mbcnt_lo_u32_b32 %0, -1, 0\n\tv_mbcnt_hi_u32_b32 %0, -1, %0" : "=v"(tl)); tl += wave * 64; asm volatile("" : "+v"(tl));        \
    const int lane = tl & 63; int G = Gk; asm volatile("" : "+s"(G)); const int NGW = G * NWAVES; (void)NGW; \
    const __attribute__((address_space(4))) Args* ap = (const __attribute__((address_space(4))) Args*)__builtin_amdgcn_kernarg_segment_ptr(); asm volatile("" : "+s"(ap)); \
    unsigned char* wl = ap->ws; \
    float* xs = ap->out; bf16_t* XB = (bf16_t*)(wl + WS_XB); (void)XB; bf16_t* ACT = (bf16_t*)(wl + WS_ACT); bf16_t* BIG = (bf16_t*)(wl + WS_BIG); int* cnt = (int*)(wl + WS_CTL) + CW_CNT; \
    int* row_t = (int*)(wl + WS_ROWT); float* row_g = (float*)(wl + WS_ROWG); (void)lane; (void)xs; (void)ACT; (void)BIG; (void)cnt; (void)row_t; (void)row_g

    if (PH_ON) {
        PH_LOCALS;
        bf16_t* Win_t = (bf16_t*)(wl + WS_WIN); bf16_t* Wout_t = (bf16_t*)(wl + WS_WOUT); bf16_t* Wgu_t = (bf16_t*)(wl + WS_WGU); bf16_t* Wd_t = (bf16_t*)(wl + WS_WD);

        LAS float* scr = (LAS float*)(lds + RING_OFF + wave * 16384);
        { f32x4 v[4], na[4], nb[4];
          load_row(ap->in[0] + (size_t)gw * DM, lane, na);
          load_row(ap->in[0] + (size_t)((gw + NGW < M) ? gw + NGW : gw) * DM, lane, nb);
          for (int m = gw; m < M; m += 2 * NGW) {
#pragma unroll
              for (int j = 0; j < 4; ++j) v[j] = na[j];
              if (m + 2 * NGW < M) load_row(ap->in[0] + (size_t)(m + 2 * NGW) * DM, lane, na);
              { float s2 = 0.f;
#pragma unroll
                for (int j = 0; j < 4; ++j) s2 += (v[j].x * v[j].x + v[j].y * v[j].y) + (v[j].z * v[j].z + v[j].w * v[j].w);
                s2 = wave_sum(s2);
                if (lane < 16) ((float*)(wl + WS_SSQ))[(size_t)m * 16 + lane] = lane == 0 ? s2 : 0.f;
                store_row_bf16(XB + (size_t)m * DM, lane, v); }
              if (m + NGW < M) {
#pragma unroll
                  for (int j = 0; j < 4; ++j) v[j] = nb[j];
                  if (m + 3 * NGW < M) load_row(ap->in[0] + (size_t)(m + 3 * NGW) * DM, lane, nb);
                  float s2 = 0.f;
#pragma unroll
                  for (int j = 0; j < 4; ++j) s2 += (v[j].x * v[j].x + v[j].y * v[j].y) + (v[j].z * v[j].z + v[j].w * v[j].w);
                  s2 = wave_sum(s2);
                  if (lane < 16) ((float*)(wl + WS_SSQ))[(size_t)(m + NGW) * 16 + lane] = lane == 0 ? s2 : 0.f;
                  store_row_bf16(XB + (size_t)(m + NGW) * DM, lane, v); } } }
#if MK_DUP & 4
        for (int rep = 0; rep < 2; ++rep)
#endif
        {
        for (int l = 0; l < 2; ++l) {
            transpose_matrix(ap->in[1] + (size_t)l * DM * QKV, DM, QKV, Win_t + (size_t)l * QKV * DM, false, 0, scr, gw, NGW, lane, ap->in[3] + l * DM, l * 2048);
            transpose_matrix(ap->in[2] + (size_t)l * DM * DM, DM, DM, Wout_t + (size_t)l * DM * DM, false, 0, scr, gw, NGW, lane, nullptr, l * 2048 + 1536);
        }
        if (DENSE_GU_FP8) {
            transpose_matrix8(ap->in[12], DM, FFD, (unsigned char*)Wgu_t, true, 0, scr, gw, NGW, lane, -32.f * LOG2E, 2048, ap->in[4]);
            transpose_matrix8(ap->in[13], DM, FFD, (unsigned char*)Wgu_t, true, 128, scr, gw, NGW, lane, -32.f / LOG2E, 2752, ap->in[4]);
        } else {
            transpose_matrix(ap->in[12], DM, FFD, Wgu_t, true, 0, scr, gw, NGW, lane, ap->in[4], 4096, -LOG2E);
            transpose_matrix(ap->in[13], DM, FFD, Wgu_t, true, 128, scr, gw, NGW, lane, ap->in[4], 5504, -1.f / LOG2E);
        }
        if (DENSE_DOWN_FP8) transpose_matrix8(ap->in[14], FFD, DM, (unsigned char*)Wd_t, false, 0, scr, gw, NGW, lane, 32.f, 1408);
        else transpose_matrix(ap->in[14], FFD, DM, Wd_t, false, 0, scr, gw, NGW, lane, nullptr, 6912);
        }
    }
    PH_END;

    for (int layer = 0; layer < 2; ++layer) {
        const float lambda_init = layer == 0 ? 0.2f : 0.35550906759f;
        if (PH_ON) {
            PH_LOCALS;
            pg8::Gemm g{XB, (bf16_t*)(wl + WS_WIN) + (size_t)layer * QKV * DM, DM}; pg8::StaticOrder S; S.init(M / 256, QKV / 256, G, bx);
            pg8::EpiProj E{BIG, (unsigned char*)BIG + (size_t)M * DM * 2, (unsigned char*)BIG + (size_t)M * DM * 4, (const float*)(wl + WS_SSQ)};
#if !(MK_SKIP & 16)
            pg8::gemm_phase<pg8::EpiProj, pg8::StaticOrder, true, false>(lds + RING_OFF, g, S, E, nullptr, tl);
#endif
#if MK_DUP & 8
            if (layer == 0) pg8::gemm_phase<pg8::EpiProj, pg8::StaticOrder, true, false>(lds + RING_OFF, g, S, E, nullptr, tl);
#endif
        }
        PH_END;
        if (PH_ON) {
            PH_LOCALS;
            LAS float* tbl = (LAS float*)(lds + TBL_OFF);
            for (int i = tl; i < 4 * 132; i += NWAVES * 64) { const int h = i / 132, d = i % 132; const int dd = d > 128 ? 128 : d;
                int bk = dd; if (dd >= 16) { bk = 16 + (int)(log2f((float)dd * (1.f / 16.f)) * (16.f / 3.f)); bk = bk > 31 ? 31 : bk; }
                tbl[i] = (ap->in[11][bk * 4 + h] - ap->in[11][31 * 4 + h]) * LOG2E; }
            if (tl < 192) ((LAS float*)(lds + GTAB_OFF))[tl] = tl < 128 ? ap->in[6][layer * 128 + tl] : ap->in[5][layer * 64 + tl - 128];
            if (wave == 0) { const float a = wave_sum(ap->in[7][layer * 64 + lane] * ap->in[8][layer * 64 + lane]), b2 = wave_sum(ap->in[9][layer * 64 + lane] * ap->in[10][layer * 64 + lane]);
                if (lane == 0) tbl[4 * 132] = expf(a) - expf(b2) + lambda_init; }
            __syncthreads();
            for (int i = tl; i < 4 * 4 * BT_N; i += NWAVES * 64) { const int h = i / (4 * BT_N), cpy = (i / BT_N) & 3, m = i % BT_N;
                int d = (BT_N - 1) - (m + cpy) - 100; d = d < 0 ? 0 : (d > 128 ? 128 : d);
                ((LAS float*)(lds + BT_OFF))[i] = tbl[h * 132 + d]; }
            __syncthreads();
            const unsigned char* KTb = (const unsigned char*)BIG + (size_t)M * DM * 2; const unsigned char* VTb = KTb + (size_t)M * DM * 2;
            att::Params PD{BIG, KTb, VTb, ACT, GTAB_OFF, tbl[4 * 132], 1.f - lambda_init};
            att::Params PS{BIG, KTb, VTb, ACT, GTAB_OFF + 512, 0.f, 1.f};
            auto convert_experts = [&]() {
                __syncthreads();
                LAS float* scr = (LAS float*)(lds + RING_OFF + wave * 16384);
                for (int e = 0; e < NE; ++e) {
                    transpose_matrix8(ap->in[16] + (size_t)e * DM * FFE, DM, FFE, (unsigned char*)(wl + WS_EGU8) + (size_t)e * NGU_E * DM, true, 0, scr, gw, NGW, lane, -32.f * LOG2E, (3 * e) * 896);
                    transpose_matrix8(ap->in[17] + (size_t)e * DM * FFE, DM, FFE, (unsigned char*)(wl + WS_EGU8) + (size_t)e * NGU_E * DM, true, 128, scr, gw, NGW, lane, -32.f / LOG2E, (3 * e + 1) * 896);
                    transpose_matrix8(ap->in[18] + (size_t)e * FFE * DM, FFE, DM, (unsigned char*)(wl + WS_ED) + (size_t)e * DM * FFE, false, 0, scr, gw, NGW, lane, 32.f, (3 * e + 2) * 896);
                }
                __syncthreads();
            };
            const bool conv_first = ((bx >> 3) & 1) == 0;
            if (layer == 1 && conv_first) convert_experts();
#if MK_DUP & 1
            for (int rep = 0; rep < (layer == 0 ? 2 : 1); ++rep)
#endif
            bf16x8 qfr[4];
#pragma unroll
            for (int d0 = 0; d0 < 4; ++d0) qfr[d0] = (bf16x8){0, 0, 0, 0, 0, 0, 0, 0};
            for (int ux = vcu; ux < 1024; ux += G) { const int i = ux >> 8, v = ux & 255, bp = v >> 3, s = v & 7;
                const int qb = (i == 0) ? s : (i == 1) ? 15 - s : (i == 2) ? 16 + s : 31 - s;
                const int un = ux + G, i2 = un >> 8, v2 = un & 255, bp2 = v2 >> 3, s2 = v2 & 7;
                const int qb2 = (i2 == 0) ? s2 : (i2 == 1) ? 15 - s2 : (i2 == 2) ? 16 + s2 : 31 - s2;
#if !(MK_SKIP & 1)
                att::unit<false>(lds, PD, bp >> 2, bp & 3, qb, tl, qfr, ux == vcu, un < 1024, bp2 >> 2, bp2 & 3, qb2);
#endif
            }
#if MK_DUP & 2
            for (int rep = 0; rep < (layer == 0 ? 2 : 1); ++rep)
#endif
            for (int ux = vcu; ux < 1024; ux += G) { const int i = ux >> 8, v = ux & 255, bp = v >> 3, s = v & 7;
                const int qb = (i == 0) ? s : (i == 1) ? 15 - s : (i == 2) ? 16 + s : 31 - s;
                const int un = ux + G, i2 = un >> 8, v2 = un & 255, bp2 = v2 >> 3, s2 = v2 & 7;
                const int qb2 = (i2 == 0) ? s2 : (i2 == 1) ? 15 - s2 : (i2 == 2) ? 16 + s2 : 31 - s2;
#if !(MK_SKIP & 2)
                att::unit<true>(lds, PS, bp >> 2, bp & 3, qb, tl, qfr, ux == vcu, un < 1024, bp2 >> 2, bp2 & 3, qb2);
#endif
            }
            if (layer == 1 && !conv_first) convert_experts();
        }
        PH_END;
        if (PH_ON) {
            PH_LOCALS;
            pg8::Gemm g{ACT, (bf16_t*)(wl + WS_WOUT) + (size_t)layer * DM * DM, DM}; pg8::StaticOrder S; S.init(M / 256, DM / 256, G, bx);
            if (DENSE_GU_FP8 && layer == 0) {
                pg8::EpiRes<true> E{XB, (float*)(wl + WS_SSQ), wl + WS_ACT8};
                pg8::gemm_phase<pg8::EpiRes<true>, pg8::StaticOrder, true, false>(lds + RING_OFF, g, S, E, nullptr, tl);
            } else {
                pg8::EpiRes<false> E{XB, (float*)(wl + WS_SSQ)};
                pg8::gemm_phase<pg8::EpiRes<false>, pg8::StaticOrder, true, false>(lds + RING_OFF, g, S, E, nullptr, tl);
            }

        }
        PH_END;
        if (layer == 1) {
        if (PH_ON) {
            PH_LOCALS;
            const float* gain = ap->in[4] + layer * DM;
            {
                int* tok_e = (int*)(wl + WS_TOKE); int* tok_p = (int*)(wl + WS_TOKP); float* tok_g = (float*)(wl + WS_TOKG);
                LAS float* rw = (LAS float*)(lds + RING_OFF);
                LAS int* se = (LAS int*)(lds + RING_OFF + 32768);
                LAS float* sg = (LAS float*)(lds + RING_OFF + 32768 + 1024);
                LAS int* srank = (LAS int*)(lds + RING_OFF + 32768 + 2048);
                LAS int* sbase = (LAS int*)(lds + RING_OFF + 32768 + 3072);
                LAS float* gl = (LAS float*)(lds + RING_OFF + 40960);
                gl[tl] = gain[tl]; gl[tl + NWAVES * 64] = gain[tl + NWAVES * 64];
                { f32x4 rv[4];
#pragma unroll
                  for (int j = 0; j < 4; ++j) rv[j] = *(const GAS f32x4*)(ap->in[15] + 4 * (tl + j * NWAVES * 64));
#pragma unroll
                  for (int j = 0; j < 4; ++j) { const int i4 = tl + j * NWAVES * 64, col = i4 >> 1, e0 = (i4 & 1) * 4;
                      rw[(e0 + 0) * DM + col] = rv[j].x; rw[(e0 + 1) * DM + col] = rv[j].y; rw[(e0 + 2) * DM + col] = rv[j].z; rw[(e0 + 3) * DM + col] = rv[j].w; } }
#pragma unroll 1
                for (int i = bx * NWAVES * 64 + tl; i < 2 * MOE_ROWS; i += G * NWAVES * 64) row_t[i] = -1;
                __syncthreads();
                for (int blk = vcu; blk < M / 128; blk += G) {
                    u32x2 na[4], nb[4]; const bf16_t* xb0 = XB + (size_t)(blk * 128 + wave * 16) * DM;
                    load_row_bf(xb0, lane, na); load_row_bf(xb0 + DM, lane, nb);
#pragma unroll 1
                    for (int rr = 0; rr < 16; rr += 2) { const int lr = wave * 16 + rr, m = blk * 128 + lr;
                        f32x4 v0[4], v1[4]; cvt_row(na, v0); cvt_row(nb, v1);
                        { const int r2 = (rr + 2 < 16) ? rr + 2 : rr;
                          load_row_bf(xb0 + (size_t)r2 * DM, lane, na); load_row_bf(xb0 + (size_t)(r2 + 1) * DM, lane, nb); }
                        norm_row_l(gl, lane, v0); norm_row_l(gl, lane, v1);
                        { GAS unsigned* o8 = (GAS unsigned*)(wl + WS_ACT8 + (size_t)m * DM) + lane;
#pragma unroll
                          for (int j = 0; j < 4; ++j) { o8[64 * j] = pk4_fp8(v0[j].x, v0[j].y, v0[j].z, v0[j].w); o8[DM / 4 + 64 * j] = pk4_fp8(v1[j].x, v1[j].y, v1[j].z, v1[j].w); } }
                        float la[NE], lb[NE];
#pragma unroll
                        for (int e = 0; e < NE; ++e) { la[e] = 0.f; lb[e] = 0.f; }
#pragma unroll
                        for (int j = 0; j < 4; ++j) { f32x4 w[NE];
#pragma unroll
                            for (int e = 0; e < NE; ++e) w[e] = *(const LAS f32x4*)(rw + e * DM + 4 * lane + 256 * j);
                            asm volatile("" ::: "memory");
#pragma unroll
                            for (int e = 0; e < NE; ++e) {
                                la[e] += (v0[j].x * w[e].x + v0[j].y * w[e].y) + (v0[j].z * w[e].z + v0[j].w * w[e].w); lb[e] += (v1[j].x * w[e].x + v1[j].y * w[e].y) + (v1[j].z * w[e].z + v1[j].w * w[e].w); } }
#pragma unroll
                        for (int e = 0; e < NE; ++e) { la[e] = wave_sum(la[e]); lb[e] = wave_sum(lb[e]); }
#pragma unroll
                        for (int h = 0; h < 2; ++h) {
                            int i1 = 0; float l1 = h ? lb[0] : la[0];
#pragma unroll
                            for (int e = 1; e < NE; ++e) { const float le = h ? lb[e] : la[e]; if (le > l1) { l1 = le; i1 = e; } }
                            int i2 = -1; float l2 = -INFINITY;
#pragma unroll
                            for (int e = 0; e < NE; ++e) { const float le = h ? lb[e] : la[e]; if (e != i1 && le > l2) { l2 = le; i2 = e; } }
                            const float ex = expf(l2 - l1), g1 = 1.f / (1.f + ex), g2 = ex * g1;
                            if (lane == 0) { se[lr + h] = i1; se[128 + lr + h] = i2; sg[lr + h] = g1; sg[128 + lr + h] = g2; }
                        }
                    }
                    __syncthreads();
                    if (tl < 16) { const int k = tl >> 3, e = tl & 7; int c = 0;
                        typedef int se4_t __attribute__((ext_vector_type(4))); const LAS se4_t* sp = (const LAS se4_t*)(se + k * 128);
                        for (int r4 = 0; r4 < 32; ++r4) { const se4_t q = sp[r4]; LAS int* sr = srank + k * 128 + 4 * r4;
                            if (q.x == e) { sr[0] = c; ++c; } if (q.y == e) { sr[1] = c; ++c; } if (q.z == e) { sr[2] = c; ++c; } if (q.w == e) { sr[3] = c; ++c; } }
                        sbase[tl] = c ? (int)__hip_atomic_fetch_add((unsigned*)&cnt[tl], (unsigned)c, RLX_AGENT) : 0; }
                    __syncthreads();
                    if (tl < 256) { const int k = tl >> 7, r = tl & 127, m = blk * 128 + r, e = se[k * 128 + r];
                        tok_e[k * M + m] = e; tok_p[k * M + m] = sbase[k * 8 + e] + srank[k * 128 + r]; tok_g[k * M + m] = sg[k * 128 + r]; }
                    __syncthreads();
                }
            }
        }
        PH_END;
        }
        if (layer == 0) {
            if (PH_ON) {
                PH_LOCALS;
                pg8::Gemm g{DENSE_GU_FP8 ? (const bf16_t*)(wl + WS_ACT8) : XB, (bf16_t*)(wl + WS_WGU), DM, DENSE_GU_FP8 ? 0x7C7C7C7C : 0x7F7F7F7F, (DENSE_GU_FP8 && DENSE_DOWN_FP8) ? 0x7D7D7D7D : 0x7A7A7A7A};
                pg8::StaticOrder S; S.init(M / 256, NGU_D / 256, G, bx);
                pg8::EpiSwiGLU<true, DENSE_DOWN_FP8 != 0> E{BIG, FFD, NGU_D / 256, (const float*)(wl + WS_SSQ)};
#if !(MK_SKIP & 64)
                pg8::gemm_phase<pg8::EpiSwiGLU<true, DENSE_DOWN_FP8 != 0>, pg8::StaticOrder, true, false, DENSE_GU_FP8 != 0>(lds + RING_OFF, g, S, E, nullptr, tl);
#endif
#if MK_DUP & 16
                pg8::gemm_phase<pg8::EpiSwiGLU<true, DENSE_DOWN_FP8 != 0>, pg8::StaticOrder, true, false>(lds + RING_OFF, g, S, E, nullptr, tl);
#endif
            }
            PH_END;
            if (PH_ON) {
                PH_LOCALS;
                pg8::Gemm g{BIG, (bf16_t*)(wl + WS_WD), FFD, DENSE_DOWN_FP8 ? 0x7C7C7C7C : 0x7F7F7F7F}; pg8::StaticOrder S; S.init(M / 256, DM / 256, G, bx);
                pg8::EpiRes<false> E{XB, (float*)(wl + WS_SSQ)};
#if !(MK_SKIP & 128)
                pg8::gemm_phase<pg8::EpiRes<false>, pg8::StaticOrder, true, false, DENSE_DOWN_FP8 != 0>(lds + RING_OFF, g, S, E, nullptr, tl);
#endif
            }
            PH_END;
        } else {
            if (PH_ON) {
                PH_LOCALS;
                const int* tok_e = (const int*)(wl + WS_TOKE); const int* tok_p = (const int*)(wl + WS_TOKP); const float* tok_g = (const float*)(wl + WS_TOKG);
                int tiles[16];
#pragma unroll
                for (int j = 0; j < 16; ++j) tiles[j] = cnt[j];
                asm volatile("" ::: "memory");
#pragma unroll
                for (int j = 0; j < 16; ++j) tiles[j] = (tiles[j] + 255) >> 8;
#pragma unroll 1
                for (int i = bx * NWAVES * 64 + tl; i < 2 * M; i += G * NWAVES * 64) { const int k = i / M, m = i % M, e = tok_e[i];
                    int st = 0;
#pragma unroll
                    for (int j = 0; j < 8; ++j) st += (j < e) ? (k ? tiles[8 + j] : tiles[j]) : 0;
                    const int dest = st * 256 + tok_p[i];
                    row_t[k * MOE_ROWS + dest] = m; row_g[k * MOE_ROWS + dest] = tok_g[i]; }
            }
            PH_END;
            { PH_LOCALS; if (tl == 0) { typedef int ct4_t __attribute__((ext_vector_type(4)));
                  const GAS ct4_t* cp = (const GAS ct4_t*)cnt; const ct4_t c0 = cp[0], c1 = cp[1], c2 = cp[2], c3 = cp[3];
                  asm volatile("" ::: "memory");
                  const int cv[16] = {c0.x, c0.y, c0.z, c0.w, c1.x, c1.y, c1.z, c1.w, c2.x, c2.y, c2.z, c2.w, c3.x, c3.y, c3.z, c3.w};
#pragma unroll
                  for (int k = 0; k < 2; ++k) { int st = 0;
#pragma unroll
                      for (int e = 0; e < NE; ++e) { st += (cv[k * 8 + e] + 255) >> 8; MISC[16 + 8 * k + e] = (unsigned)st; } } } }
            __syncthreads();
            const int T0 = (int)MISC[16 + NE - 1], T1 = (int)MISC[24 + NE - 1];
            const int h0 = (T0 + 1) >> 1, h1 = (T1 - 64 > ((T1 + 1) >> 1)) ? T1 - 64 : ((T1 + 1) >> 1);
#pragma unroll 1
            for (int ci = -1; ci < 3; ++ci) {
                if (PH_ON) {
                    PH_LOCALS;
                    const int cd = ci, cg = ci + 1;
                    const int d_t0 = (cd == 2) ? h1 : 0, d_t1 = (cd == 0) ? T0 : (cd == 1) ? h1 : T1;
                    const int g_t0 = (cg == 2) ? h1 : 0, g_t1 = (cg == 0) ? T0 : (cg == 1) ? h1 : T1; (void)h0;
                    const int Ld = (cd >= 0) ? (d_t1 - d_t0) * (DM / 256) : 0;
                    if (cd >= 0) {
                        const int k = cd > 0 ? 1 : 0; bf16_t* HB = (bf16_t*)(wl + ((cd == 1) ? WS_HB1 : WS_BIG));
                        pg8::Gemm g{(const bf16_t*)((const unsigned char*)HB - (size_t)d_t0 * 256 * FFE), (const bf16_t*)(wl + WS_ED), FFE, 0x7C7C7C7C};
                        pg8::ChunkOrder S; S.S.init(d_t1 - d_t0, DM / 256, G, bx); S.t0 = d_t0; S.tend = (const volatile LAS int*)(MISC + 16 + 8 * k); S.xe = 0; S.li = 0; S.nl = 0; S.E = 0;
                        pg8::EpiMoeDown E{XB, row_t + k * MOE_ROWS, row_g + k * MOE_ROWS, 1.f};
#if !(MK_SKIP & 8)
                        pg8::gemm_phase<pg8::EpiMoeDown, pg8::ChunkOrder, true, false, true>(lds + RING_OFF, g, S, E, nullptr, tl);
#endif
                    }
                    if (cg < 3) {
                        const int k = cg > 0 ? 1 : 0; bf16_t* HB = (bf16_t*)(wl + ((cg == 1) ? WS_HB1 : WS_BIG));
                        pg8::Gemm g{(const bf16_t*)(wl + WS_ACT8), (const bf16_t*)(wl + WS_EGU8), DM, 0x7F7F7F7F, 0x7D7D7D7D};
                        pg8::ChunkOrder S; S.S.init(g_t1 - g_t0, NGU_E / 256, G, bx); S.t0 = g_t0; S.tend = (const volatile LAS int*)(MISC + 16 + 8 * k);
                        const int rem = Ld % G; S.xe = 0; S.li = 0; S.nl = 0; S.E = 0;
                        if (rem > 0) { S.nl = G - rem; const int Ecap = 4 * S.nl; S.E = S.S.nwg < Ecap ? S.S.nwg : Ecap;
                            if (bx >= rem) { S.li = bx - rem; for (int q = 0; q < 4; ++q) S.xe += (S.li + q * S.nl < S.E) ? 1 : 0; } }
                        pg8::EpiSwiGLU<false, true> E{(bf16_t*)((unsigned char*)HB - (size_t)g_t0 * 256 * FFE), FFE, NGU_E / 256, nullptr};
#if !(MK_SKIP & 4)
                        pg8::gemm_phase<pg8::EpiSwiGLU<false, true>, pg8::ChunkOrder, true, true, true>(lds + RING_OFF, g, S, E, row_t + k * MOE_ROWS, tl);
#endif
                    }
                }
                PH_END;
            }
#if MK_DUP & 1024
            for (int rep = 0; rep < 16; ++rep) xcd_barrier(bar);
#endif
            if (PH_ON) {
                PH_LOCALS;
                LAS float* gl = (LAS float*)(lds + RING_OFF);
                gl[tl] = ap->in[19][tl]; gl[tl + NWAVES * 64] = ap->in[19][tl + NWAVES * 64];
                __syncthreads();
                f32x4 v[4]; u32x2 na[4], nb[4];
                load_row_bf<true>(XB + (size_t)gw * DM, lane, na);
                load_row_bf<true>(XB + (size_t)((gw + NGW < M) ? gw + NGW : gw) * DM, lane, nb);
                for (int m = gw; m < M; m += 2 * NGW) {
                    cvt_row(na, v);
                    if (m + 2 * NGW < M) load_row_bf<true>(XB + (size_t)(m + 2 * NGW) * DM, lane, na);
                    norm_row_l(gl, lane, v);
                    { GAS f32x4* o = (GAS f32x4*)(xs + (size_t)m * DM) + lane;
#pragma unroll
                      for (int j = 0; j < 4; ++j) __builtin_nontemporal_store(v[j], o + 64 * j); }
                    if (m + NGW < M) {
                        cvt_row(nb, v);
                        if (m + 3 * NGW < M) load_row_bf<true>(XB + (size_t)(m + 3 * NGW) * DM, lane, nb);
                        norm_row_l(gl, lane, v);
                        GAS f32x4* o = (GAS f32x4*)(xs + (size_t)(m + NGW) * DM) + lane;
#pragma unroll
                        for (int j = 0; j < 4; ++j) __builtin_nontemporal_store(v[j], o + 64 * j); } }
            }
            ++ph;
        }
    }
#undef PH_ON
#undef PH_END
#undef PH_LOCALS
}

#ifndef MK_SKIP
#define MK_SKIP 0
#endif
#ifndef MK_N_LAUNCHES
#define MK_N_LAUNCHES 1
#endif
constexpr int N_PHASES = 16;
extern "C" void kernel_launch(void* const* d_in, const int* in_sizes, int n_in, void* d_out, int out_size, void* d_ws, size_t ws_size, hipStream_t stream) {
    static int grid = 0;
    if (grid == 0) {
        if (n_in != 20 || in_sizes[0] != M * DM || out_size != M * DM || ws_size < WS_END) { fprintf(stderr, "kernel_launch: unexpected shapes / workspace (n_in %d, ws %zu < %zu)\n", n_in, ws_size, (size_t)WS_END); grid = -1; return; }
        int dev = 0, cus = 0, per_cu = 0;
        if (hipGetDevice(&dev) != hipSuccess || hipDeviceGetAttribute(&cus, hipDeviceAttributeMultiprocessorCount, dev) != hipSuccess) { grid = -1; return; }
        if (hipFuncSetAttribute((const void*)mk_fwd, hipFuncAttributeMaxDynamicSharedMemorySize, LDS_BYTES) != hipSuccess) { fprintf(stderr, "kernel_launch: hipFuncSetAttribute failed\n"); grid = -1; return; }
        if (hipOccupancyMaxActiveBlocksPerMultiprocessor(&per_cu, (const void*)mk_fwd, NWAVES * 64, LDS_BYTES) != hipSuccess || per_cu < 1) { fprintf(stderr, "kernel_launch: occupancy query says %d\n", per_cu); }
        (void)hipGetLastError();
        grid = cus;
    }
    if (grid < 0) return;
    if (hipMemsetAsync((char*)d_ws + WS_CTL, 0, CTL_ZERO_BYTES, stream) != hipSuccess) return;
    Args a{};
    for (int i = 0; i < 20; ++i) a.in[i] = (const float*)d_in[i];
    a.out = (float*)d_out; a.ws = (unsigned char*)d_ws;
#if MK_N_LAUNCHES == 1
    a.ph_lo = 0; a.ph_hi = N_PHASES;
    hipLaunchKernelGGL(mk_fwd, dim3(grid), dim3(NWAVES * 64), LDS_BYTES, stream, a);
#else
    for (int p = 0; p < N_PHASES; ++p) { a.ph_lo = p; a.ph_hi = p + 1; hipLaunchKernelGGL(mk_fwd, dim3(grid), dim3(NWAVES * 64), LDS_BYTES, stream, a); }
#endif
}
```
